# Optimizing an MI355X kernel written in HIP

```python
import math
import jax, jax.numpy as jnp
from jax import lax
import numpy as np

D_MODEL = 1024
BATCH = 32
SEQ = 2048
DEPTH = 2

A_HEADS = 4
A_HEAD_DIM = 64
B_HEADS = 4
B_HEAD_DIM = 128
B_PATTERNS = ((128, 1), (512, 4), (2048, 16))
C_HEADS = 8
C_NOPE_DIM = 64
C_ROPE_DIM = 32
C_V_DIM = 64
C_Q_LORA = 384
C_KV_LORA = 256
ROPE_THETA = 10000.0
FFN_HIDDEN = -(-8 * D_MODEL // (3 * 256)) * 256
A_QK_W = A_HEADS * 2 * A_HEAD_DIM
A_V_W = A_HEADS * 2 * A_HEAD_DIM
B_W = B_HEADS * B_HEAD_DIM
C_DKV_W = C_KV_LORA + C_ROPE_DIM
C_OUT_W = C_HEADS * C_V_DIM
N_BRANCHES = 3
IN_SPLITS = (A_QK_W, A_QK_W, A_V_W, B_W, B_W, B_W, C_Q_LORA, C_DKV_W, N_BRANCHES * D_MODEL)
IN_WIDTH = A_QK_W * 2 + A_V_W + B_W * 3 + C_Q_LORA + C_DKV_W + N_BRANCHES * D_MODEL
QBLOCK = 128
NORM_EPS = 1e-6
NEG_INF = -1e30

kernel_name = "hybrid_gated_diff_dilated_mla_block"


def _rms_norm(x, g):
    xf = x.astype(jnp.float32)
    y = xf * lax.rsqrt(jnp.mean(xf * xf, axis=-1, keepdims=True) + NORM_EPS)
    return (y * g.astype(jnp.float32)).astype(x.dtype)


def _alibi_slopes():
    n = A_HEADS + B_HEADS
    s = 2.0 ** (-8.0 * jnp.arange(1, n + 1, dtype=jnp.float32) / n)
    return s[0::2], s[1::2]


def _rope(x, pos):
    half = x.shape[-1] // 2
    inv_freq = ROPE_THETA ** (-jnp.arange(half, dtype=jnp.float32) / half)
    ang = pos.astype(jnp.float32)[:, None] * inv_freq[None, :]
    cos, sin = jnp.cos(ang)[:, None, :], jnp.sin(ang)[:, None, :]
    xf = x.astype(jnp.float32)
    x1, x2 = xf[..., :half], xf[..., half:]
    return jnp.concatenate([x1 * cos - x2 * sin, x1 * sin + x2 * cos], axis=-1).astype(x.dtype)


def _block_geometry(start, end):
    qpos = jnp.arange(start, end)
    kpos = jnp.arange(end)
    dist = (qpos[:, None] - kpos[None, :]).astype(jnp.float32)
    return dist >= 0, dist


def _causal_block_sweep(block_fn, seq):
    qb = min(QBLOCK, seq)
    return jnp.concatenate([block_fn(s, min(s + qb, seq)) for s in range(0, seq, qb)], axis=1)


def _diff_attention(q, k, v, lam, lam_init, slopes, gain):
    B, S = q.shape[:2]
    q = q.reshape(B, S, A_HEADS, 2, A_HEAD_DIM)
    k = k.reshape(B, S, A_HEADS, 2, A_HEAD_DIM)
    v = v.reshape(B, S, A_HEADS, 2 * A_HEAD_DIM)
    scale = A_HEAD_DIM ** -0.5

    def block(start, end):
        causal, dist = _block_geometry(start, end)
        s = jnp.einsum('bqhcd,bkhcd->bhcqk', q[:, start:end], k[:, :end]).astype(jnp.float32) * scale
        s = s - slopes[:, None, None, None] * dist
        s = jnp.where(causal, s, NEG_INF)
        p = jax.nn.softmax(s, axis=-1)
        p = p[:, :, 0] - lam * p[:, :, 1]
        return jnp.einsum('bhqk,bkhd->bqhd', p.astype(v.dtype), v[:, :end])

    o = _causal_block_sweep(block, S)
    o = _rms_norm(o, gain) * (1.0 - lam_init)
    return o.reshape(B, S, A_V_W)


def _strided_window_attention(q, k, v, window, dil, slopes):
    B, S, H, D = q.shape
    L = S // dil
    nw = window // dil

    def sub(t):
        return t.reshape(B, L, dil, H, D).transpose(0, 2, 1, 3, 4).reshape(B * dil, L, H, D)

    qs, ks, vs = sub(q), sub(k), sub(v)
    Bp = B * dil
    bq = min(QBLOCK, L)
    nb = L // bq
    n_prev = min(-(-nw // bq), nb - 1)
    kb_len = (n_prev + 1) * bq

    def band(t):
        tp = jnp.pad(t, ((0, 0), (n_prev * bq, 0), (0, 0), (0, 0)))
        views = [tp[:, j * bq: j * bq + L].reshape(Bp, nb, bq, H, D) for j in range(n_prev + 1)]
        return jnp.concatenate(views, axis=2)

    qb = qs.reshape(Bp, nb, bq, H, D)
    kb, vb = band(ks), band(vs)
    qi = jnp.arange(L).reshape(nb, bq)
    ki = (jnp.arange(nb)[:, None] - n_prev) * bq + jnp.arange(kb_len)[None, :]
    delta = qi[:, :, None] - ki[:, None, :]
    valid = (delta >= 0) & (delta <= nw) & (ki[:, None, :] >= 0)
    dist = (delta * dil).astype(jnp.float32)
    scale = D ** -0.5
    s = jnp.einsum('bnqhd,bnkhd->bhnqk', qb, kb).astype(jnp.float32) * scale
    s = s - slopes[:, None, None, None] * dist
    s = jnp.where(valid, s, NEG_INF)
    lse = jax.nn.logsumexp(s, axis=-1)
    p = jnp.exp(s - lse[..., None])
    o = jnp.einsum('bhnqk,bnkhd->bnqhd', p.astype(v.dtype), vb).reshape(B, dil, L, H, D)
    o = o.transpose(0, 2, 1, 3, 4).reshape(B, S, H, D)
    lse = lse.transpose(0, 2, 3, 1).reshape(B, dil, L, H).transpose(0, 2, 1, 3).reshape(B, S, H)
    return o, lse


def _dilated_attention(q, k, v, slopes):
    B, S = q.shape[:2]
    q = q.reshape(B, S, B_HEADS, B_HEAD_DIM)
    k = k.reshape(B, S, B_HEADS, B_HEAD_DIM)
    v = v.reshape(B, S, B_HEADS, B_HEAD_DIM)
    outs, lses = [], []
    for window, dil in B_PATTERNS:
        o, lse = _strided_window_attention(q, k, v, window, dil, slopes)
        outs.append(o)
        lses.append(lse)
    o = jnp.stack(outs, axis=0)
    w = jax.nn.softmax(jnp.stack(lses, axis=0), axis=0)
    o = jnp.sum(w[..., None].astype(o.dtype) * o, axis=0)
    return o.reshape(B, S, B_W)


def _mla(c_q, c_kv_pe, q_norm, w_uq, kv_norm, w_ukv, pos):
    B, S = c_q.shape[:2]
    q = (_rms_norm(c_q, q_norm) @ w_uq).reshape(B, S, C_HEADS, C_NOPE_DIM + C_ROPE_DIM)
    q_nope, q_pe = q[..., :C_NOPE_DIM], _rope(q[..., C_NOPE_DIM:], pos)
    c_kv, k_pe = c_kv_pe[..., :C_KV_LORA], c_kv_pe[..., C_KV_LORA:]
    k_pe = _rope(k_pe[:, :, None, :], pos)[:, :, 0]
    kv = (_rms_norm(c_kv, kv_norm) @ w_ukv).reshape(B, S, C_HEADS, C_NOPE_DIM + C_V_DIM)
    k_nope, v = kv[..., :C_NOPE_DIM], kv[..., C_NOPE_DIM:]
    scale = (C_NOPE_DIM + C_ROPE_DIM) ** -0.5

    def block(start, end):
        causal, _ = _block_geometry(start, end)
        s = (jnp.einsum('bqhd,bkhd->bhqk', q_nope[:, start:end], k_nope[:, :end])
             + jnp.einsum('bqhr,bkr->bhqk', q_pe[:, start:end], k_pe[:, :end])).astype(jnp.float32) * scale
        s = jnp.where(causal, s, NEG_INF)
        p = jax.nn.softmax(s, axis=-1)
        return jnp.einsum('bhqk,bkhd->bqhd', p.astype(v.dtype), v[:, :end])

    o = _causal_block_sweep(block, S)
    return o.reshape(B, S, C_OUT_W)


def _hybrid_layer(x, pos, slopes_a, slopes_b, layer_idx, attn_norm, w_in, diff_lambda, diff_norm,
                  mla_q_norm, mla_w_uq, mla_kv_norm, mla_w_ukv, w_branch_a, w_branch_b, w_branch_c,
                  w_out, ffn_norm, w_ffn_gate, w_ffn_up, w_ffn_down):
    h = _rms_norm(x, attn_norm)
    proj = h @ w_in
    offsets = np.cumsum(IN_SPLITS)[:-1].tolist()
    aq, ak, av, bq, bk, bv, c_q, c_kv_pe, gates = jnp.split(proj, offsets, axis=-1)

    lam_init = 0.8 - 0.6 * math.exp(-0.3 * layer_idx)
    lf = diff_lambda.astype(jnp.float32)
    lam = jnp.exp(jnp.sum(lf[0] * lf[1])) - jnp.exp(jnp.sum(lf[2] * lf[3])) + lam_init

    y_a = _diff_attention(aq, ak, av, lam, lam_init, slopes_a, diff_norm) @ w_branch_a
    y_b = _dilated_attention(bq, bk, bv, slopes_b) @ w_branch_b
    y_c = _mla(c_q, c_kv_pe, mla_q_norm, mla_w_uq, mla_kv_norm, mla_w_ukv, pos) @ w_branch_c
    g_a, g_b, g_c = jnp.split(jax.nn.sigmoid(gates), N_BRANCHES, axis=-1)
    x = x + (g_a * y_a + g_b * y_b + g_c * y_c) @ w_out

    h2 = _rms_norm(x, ffn_norm)
    x = x + (jax.nn.silu(h2 @ w_ffn_gate) * (h2 @ w_ffn_up)) @ w_ffn_down
    return x


def setup_inputs(seed: int = 0) -> dict:
    key = jax.random.key(seed)
    ks = jax.random.split(key, 20)

    def nrm(k, shape, scale):
        return jax.random.normal(k, shape, jnp.float32) * scale

    def gain(k, shape):
        return 1.0 + 0.02 * jax.random.normal(k, shape, jnp.float32)

    return {
        "x": nrm(ks[0], (BATCH, SEQ, D_MODEL), 1.0),
        "attn_norm": gain(ks[1], (DEPTH, D_MODEL)),
        "w_in": nrm(ks[2], (DEPTH, D_MODEL, IN_WIDTH), D_MODEL ** -0.5),
        "diff_lambda": nrm(ks[3], (DEPTH, 4, A_HEAD_DIM), 0.1),
        "diff_norm": gain(ks[4], (DEPTH, 2 * A_HEAD_DIM)),
        "mla_q_norm": gain(ks[5], (DEPTH, C_Q_LORA)),
        "mla_w_uq": nrm(ks[6], (DEPTH, C_Q_LORA, C_HEADS * (C_NOPE_DIM + C_ROPE_DIM)), C_Q_LORA ** -0.5),
        "mla_kv_norm": gain(ks[7], (DEPTH, C_KV_LORA)),
        "mla_w_ukv": nrm(ks[8], (DEPTH, C_KV_LORA, C_HEADS * (C_NOPE_DIM + C_V_DIM)), C_KV_LORA ** -0.5),
        "w_branch_a": nrm(ks[9], (DEPTH, A_V_W, D_MODEL), A_V_W ** -0.5),
        "w_branch_b": nrm(ks[10], (DEPTH, B_W, D_MODEL), B_W ** -0.5),
        "w_branch_c": nrm(ks[11], (DEPTH, C_OUT_W, D_MODEL), C_OUT_W ** -0.5),
        "w_out": nrm(ks[12], (DEPTH, D_MODEL, D_MODEL), D_MODEL ** -0.5),
        "ffn_norm": gain(ks[13], (DEPTH, D_MODEL)),
        "w_ffn_gate": nrm(ks[14], (DEPTH, D_MODEL, FFN_HIDDEN), D_MODEL ** -0.5),
        "w_ffn_up": nrm(ks[15], (DEPTH, D_MODEL, FFN_HIDDEN), D_MODEL ** -0.5),
        "w_ffn_down": nrm(ks[16], (DEPTH, FFN_HIDDEN, D_MODEL), FFN_HIDDEN ** -0.5),
        "final_norm": gain(ks[17], (D_MODEL,)),
    }


def reference(x, attn_norm, w_in, diff_lambda, diff_norm, mla_q_norm, mla_w_uq, mla_kv_norm,
              mla_w_ukv, w_branch_a, w_branch_b, w_branch_c, w_out, ffn_norm, w_ffn_gate,
              w_ffn_up, w_ffn_down, final_norm):
    pos = jnp.arange(x.shape[1], dtype=jnp.int32)
    slopes_a, slopes_b = _alibi_slopes()
    for l in range(DEPTH):
        x = _hybrid_layer(x, pos, slopes_a, slopes_b, l, attn_norm[l], w_in[l], diff_lambda[l],
                          diff_norm[l], mla_q_norm[l], mla_w_uq[l], mla_kv_norm[l], mla_w_ukv[l],
                          w_branch_a[l], w_branch_b[l], w_branch_c[l], w_out[l], ffn_norm[l],
                          w_ffn_gate[l], w_ffn_up[l], w_ffn_down[l])
    return _rms_norm(x, final_norm)
```

```cpp
#include <hip/hip_runtime.h>
#include <hip/hip_cooperative_groups.h>
#include <cstdio>
#include <cstdint>
namespace cg = cooperative_groups;

#ifndef ONE_LAUNCH
#define ONE_LAUNCH 1
#endif

#ifndef PROBE_MIX
#define PROBE_MIX -1
#endif
#ifndef DUP
#define DUP -1
#endif
#ifndef DIS
#define DIS 0
#endif
#define EN(k) (!((DIS >> (k)) & 1))
#define LAS __attribute__((address_space(3)))
#define GAS __attribute__((address_space(1)))
typedef unsigned short bf16_t;
typedef short bf16x8 __attribute__((ext_vector_type(8)));
typedef short s16x4 __attribute__((ext_vector_type(4)));
typedef float f32x4 __attribute__((ext_vector_type(4)));
typedef float f32x2 __attribute__((ext_vector_type(2)));
typedef float f32x16 __attribute__((ext_vector_type(16)));
typedef unsigned u32x4 __attribute__((ext_vector_type(4)));
typedef unsigned u32x2 __attribute__((ext_vector_type(2)));

constexpr int DM = 1024, SEQ = 2048, NBATCH = 32, TTOK = NBATCH * SEQ, INW = 6816, INP = 6912, FF = 2816;
constexpr int C_GATE = 0, C_AQ = 3072, C_AK = 3584, C_AV = 4096, C_BQ = 4608, C_BK = 5120, C_BV = 5632, C_CQ = 6144, C_CKV = 6528, C_KPE = 6784;
constexpr float NORM_EPS = 1e-6f;
constexpr float LOG2E = 1.4426950408889634f;
constexpr size_t LW_IN = 0, LW_UQ = LW_IN + (size_t)INP * 1024, LW_UKV = LW_UQ + 768 * 384, LW_A = LW_UKV + 1024 * 256, LW_B = LW_A + 1024 * 512,
                 LW_C = LW_B + 1024 * 512, LW_OUT = LW_C + 1024 * 512, LW_GU = LW_OUT + 1024 * 1024, LW_D = LW_GU + (size_t)5632 * 1024, LW_TOTAL = LW_D + (size_t)1024 * FF;
constexpr size_t MiB = 1u << 20;
constexpr size_t WS_CTL = 0, WS_ROPE = 1 * MiB, WS_W = 2 * MiB, WS_ACT = 80 * MiB;
static_assert(WS_W + 2 * LW_TOTAL * 2 <= WS_ACT, "weights fit");
constexpr size_t ACT_COLS = 1024 + INP + 768 + 1024 + 512 + 1024 + 1024 + 32;
constexpr int LDS_CTRL = 147456, LDS_BYTES = LDS_CTRL + 256;

template <class T> __device__ __forceinline__ T gld(const T* p) { return *(const GAS T*)p; }
template <class T> __device__ __forceinline__ void gst(T* p, T v) { *(GAS T*)p = v; }
__device__ __forceinline__ unsigned cvt_pk_bf16(float lo, float hi) { unsigned r; asm volatile("v_cvt_pk_bf16_f32 %0, %1, %2" : "=v"(r) : "v"(lo), "v"(hi)); return r; }
__device__ __forceinline__ float bf_lo(unsigned w) { return __uint_as_float(w << 16); }
__device__ __forceinline__ float bf_hi(unsigned w) { return __uint_as_float(w & 0xffff0000u); }
__device__ __forceinline__ float bf1(bf16_t h) { return __uint_as_float(((unsigned)h) << 16); }
__device__ __forceinline__ float fsigmoid(float x) { return __builtin_amdgcn_rcpf(1.0f + __builtin_amdgcn_exp2f(-x * LOG2E)); }
__device__ __forceinline__ int ltid() { int t = threadIdx.x; asm volatile("" : "+v"(t)); return t; }
__device__ __forceinline__ float wave_sum(float v) {
#pragma unroll
    for (int o = 1; o < 64; o <<= 1) v += __shfl_xor(v, o);
    return v;
}

namespace pg8 {
constexpr int BM = 256, BK = 64, HALF = 128, HTB = HALF * BK * 2, STAGE_BYTES = 8 * HTB, NXCD = 8, WGM = 8;
__host__ __device__ __forceinline__ int lds_byte(int r, int c) { const int st = (r >> 4) * 2 + (c >> 5), rr = r & 15, cc = c & 31, ob = rr * 64 + cc * 2; return st * 1024 + (ob ^ (((ob >> 9) & 1) << 5)); }
__host__ __device__ __forceinline__ void stage_rc(int b, int& R, int& C) { const int st = b / 1024, sb = b % 1024, swz = sb ^ (((sb >> 9) & 1) << 5); R = (st >> 1) * 16 + swz / 64; C = (st & 1) * 32 + (swz % 64) / 2; }
__host__ __device__ __forceinline__ int perm32(int rho) { const int n = rho >> 4, i = rho & 15; return 8 * (i >> 2) + 4 * n + (i & 3); }
struct Unit { int pm, pn; };
struct Gemm { const bf16_t* A; int lda; const bf16_t* Bt; int M, N, K; };
struct StaticOrder {
    int nM, nN, nwg, G, c;
    __device__ void init(int M, int N, int G_, int c_) { nM = M / BM; nN = N / BM; nwg = nM * nN; G = G_; c = c_; }
    __device__ bool next(int i, Unit& u) const {
        const long L = (long)i * G + c; if (L >= nwg) return false;
        int wgid = (int)L; { const int q = nwg / NXCD, r = nwg % NXCD, xcd = wgid % NXCD, off = wgid / NXCD; wgid = (xcd < r ? xcd * (q + 1) : r * (q + 1) + (xcd - r) * q) + off; }
        const int nig = WGM * nN, gid = wgid / nig, fm = gid * WGM, gsz = (nM - fm) < WGM ? (nM - fm) : WGM;
        u.pm = fm + ((wgid % nig) % gsz); u.pn = (wgid % nig) / gsz; return true;
    }
};
__device__ __forceinline__ void rows_rstd(const float* part, int row0, int fq, float (&rs)[2][4]) {
    f32x4 q[2][4];
#pragma unroll
    for (int ai = 0; ai < 2; ++ai)
#pragma unroll
        for (int m = 0; m < 4; ++m) q[ai][m] = gld((const f32x4*)(part + (size_t)(row0 + ai * HALF + m * 16) * 16 + 4 * fq));
#pragma unroll
    for (int ai = 0; ai < 2; ++ai)
#pragma unroll
        for (int m = 0; m < 4; ++m) { float t = (q[ai][m].x + q[ai][m].y) + (q[ai][m].z + q[ai][m].w); t += __shfl_xor(t, 16); t += __shfl_xor(t, 32); rs[ai][m] = __builtin_amdgcn_rsqf(t * (1.0f / 1024.0f) + NORM_EPS); }
}
struct EpiStore {
    static constexpr bool PERM = true;
    bf16_t* O; int ldc; int nsig; const float* part; int qsc;
    __device__ __forceinline__ void operator()(const f32x4 (&acc)[2][2][4][2], const Unit& u, int wr, int wc, int fr, int fq) const {
        const int row0 = u.pm * BM + wr * 64 + fr, col0 = u.pn * BM + wc * 32 + 8 * fq; const bool sg = u.pn < nsig;
        float rsv[2][4];
#pragma unroll
        for (int ai = 0; ai < 2; ++ai)
#pragma unroll
            for (int m = 0; m < 4; ++m) rsv[ai][m] = 1.0f;
        if (part) rows_rstd(part, row0, fq, rsv);
        const float ts = !qsc ? 1.0f : ((unsigned)(u.pn - 12) < 2u ? 0.125f * LOG2E : ((unsigned)(u.pn - 18) < 2u ? 0.08838834764831845f * LOG2E : 1.0f));
#pragma unroll
        for (int ai = 0; ai < 2; ++ai)
#pragma unroll
            for (int m = 0; m < 4; ++m) { const size_t row = (size_t)(row0 + ai * HALF + m * 16); bf16_t* rowp = O + row * ldc + col0; const float rs = rsv[ai][m] * ts;
#pragma unroll
                for (int bj = 0; bj < 2; ++bj) { f32x4 v0 = acc[ai][bj][m][0] * rs, v1 = acc[ai][bj][m][1] * rs;
                    if (sg) {
#pragma unroll
                        for (int e = 0; e < 4; ++e) { v0[e] = fsigmoid(v0[e]); v1[e] = fsigmoid(v1[e]); } }
                    u32x4 w; w.x = cvt_pk_bf16(v0[0], v0[1]); w.y = cvt_pk_bf16(v0[2], v0[3]); w.z = cvt_pk_bf16(v1[0], v1[1]); w.w = cvt_pk_bf16(v1[2], v1[3]);
                    gst((u32x4*)(rowp + bj * HALF), w); } }
    }
};
struct EpiGate {
    static constexpr bool PERM = true;
    const bf16_t* G; int ldg; bf16_t* MIX; int ldm; int first;
    __device__ __forceinline__ void operator()(const f32x4 (&acc)[2][2][4][2], const Unit& u, int wr, int wc, int fr, int fq) const {
        const int row0 = u.pm * BM + wr * 64 + fr, col0 = u.pn * BM + wc * 32 + 8 * fq;
        u32x4 g[2][2], o[2][2];
#define EG_LOAD(slot, it) do { const size_t row_ = (size_t)(row0 + ((it) >> 2) * HALF + ((it) & 3) * 16); _Pragma("unroll") for (int bj = 0; bj < 2; ++bj) { \
            g[slot][bj] = gld((const u32x4*)(G + row_ * ldg + col0 + bj * HALF)); o[slot][bj] = (u32x4){0u, 0u, 0u, 0u}; if (!first) o[slot][bj] = gld((const u32x4*)(MIX + row_ * ldm + col0 + bj * HALF)); } } while (0)
        EG_LOAD(0, 0);
#pragma unroll
        for (int it = 0; it < 8; ++it) { const int ai = it >> 2, m = it & 3, sl = it & 1; const size_t row = (size_t)(row0 + ai * HALF + m * 16);
            if (it + 1 < 8) EG_LOAD(sl ^ 1, it + 1);
#pragma unroll
            for (int bj = 0; bj < 2; ++bj) { const u32x4 gg = g[sl][bj], oo = o[sl][bj]; const f32x4 v0 = acc[ai][bj][m][0], v1 = acc[ai][bj][m][1]; u32x4 w;
                w.x = cvt_pk_bf16(bf_lo(oo.x) + bf_lo(gg.x) * v0[0], bf_hi(oo.x) + bf_hi(gg.x) * v0[1]);
                w.y = cvt_pk_bf16(bf_lo(oo.y) + bf_lo(gg.y) * v0[2], bf_hi(oo.y) + bf_hi(gg.y) * v0[3]);
                w.z = cvt_pk_bf16(bf_lo(oo.z) + bf_lo(gg.z) * v1[0], bf_hi(oo.z) + bf_hi(gg.z) * v1[1]);
                w.w = cvt_pk_bf16(bf_lo(oo.w) + bf_lo(gg.w) * v1[2], bf_hi(oo.w) + bf_hi(gg.w) * v1[3]);
                gst((u32x4*)(MIX + row * ldm + col0 + bj * HALF), w); }
            asm volatile("" ::: "memory"); }
#undef EG_LOAD
    }
};
struct EpiResid {
    static constexpr bool PERM = true;
    const float* xin; float* xout; bf16_t* XB; float* part;
    __device__ __forceinline__ void operator()(const f32x4 (&acc)[2][2][4][2], const Unit& u, int wr, int wc, int fr, int fq) const {
        const int row0 = u.pm * BM + wr * 64 + fr, col0 = u.pn * BM + wc * 32 + 8 * fq;
        f32x4 xi[2][2][2];
#define ER_LOAD(slot, it) do { const size_t off_ = (size_t)(row0 + ((it) >> 2) * HALF + ((it) & 3) * 16) * DM + col0; _Pragma("unroll") for (int bj = 0; bj < 2; ++bj) _Pragma("unroll") for (int n = 0; n < 2; ++n) \
            xi[slot][bj][n] = gld((const f32x4*)(xin + off_ + bj * HALF + n * 4)); } while (0)
        ER_LOAD(0, 0);
#pragma unroll
        for (int it = 0; it < 8; ++it) { const int ai = it >> 2, m = it & 3, sl = it & 1; const size_t row = (size_t)(row0 + ai * HALF + m * 16), off = row * DM + col0; float ssq = 0.f;
            if (it + 1 < 8) ER_LOAD(sl ^ 1, it + 1);
#pragma unroll
            for (int bj = 0; bj < 2; ++bj) { const size_t c = off + bj * HALF;
                const f32x4 v0 = xi[sl][bj][0] + acc[ai][bj][m][0], v1 = xi[sl][bj][1] + acc[ai][bj][m][1];
                gst((f32x4*)(xout + c), v0); gst((f32x4*)(xout + c + 4), v1);
                ssq += ((v0.x * v0.x + v0.y * v0.y) + (v0.z * v0.z + v0.w * v0.w)) + ((v1.x * v1.x + v1.y * v1.y) + (v1.z * v1.z + v1.w * v1.w));
                if (XB) { u32x4 w; w.x = cvt_pk_bf16(v0.x, v0.y); w.y = cvt_pk_bf16(v0.z, v0.w); w.z = cvt_pk_bf16(v1.x, v1.y); w.w = cvt_pk_bf16(v1.z, v1.w); gst((u32x4*)(XB + c), w); } }
            if (XB) { ssq += __shfl_xor(ssq, 16); ssq += __shfl_xor(ssq, 32);
            if (fq == 0) gst(part + row * 16 + u.pn * 4 + wc, ssq); }
            asm volatile("" ::: "memory"); }
#undef ER_LOAD
    }
};
struct EpiSwiGLU {
    static constexpr bool PERM = true;
    bf16_t* U; int ldu; const float* part;
    __device__ __forceinline__ void operator()(const f32x4 (&acc)[2][2][4][2], const Unit& u, int wr, int wc, int fr, int fq) const {
        const int row0 = u.pm * BM + wr * 64 + fr, f0 = u.pn * 128 + wc * 32 + 8 * fq;
        float rsv[2][4]; rows_rstd(part, row0, fq, rsv);
#pragma unroll
        for (int ai = 0; ai < 2; ++ai)
#pragma unroll
            for (int m = 0; m < 4; ++m) { const size_t row = (size_t)(row0 + ai * HALF + m * 16); const float rs = rsv[ai][m]; float r[8];
#pragma unroll
                for (int n = 0; n < 2; ++n) { const f32x4 g = acc[ai][0][m][n] * rs, up = acc[ai][1][m][n] * rs;
#pragma unroll
                    for (int e = 0; e < 4; ++e) r[4 * n + e] = g[e] * fsigmoid(g[e]) * up[e]; }
                u32x4 w; w.x = cvt_pk_bf16(r[0], r[1]); w.y = cvt_pk_bf16(r[2], r[3]); w.z = cvt_pk_bf16(r[4], r[5]); w.w = cvt_pk_bf16(r[6], r[7]);
                gst((u32x4*)(U + row * ldu + f0), w); }
    }
};

template <class Epi, bool ALIGN_EPI>
__device__ __forceinline__ void gemm_phase(LAS unsigned char* lds, const Gemm g, const StaticOrder& S, const Epi& E) {
    const int tid = ltid(), wid = __builtin_amdgcn_readfirstlane(tid >> 6), lane = tid & 63, wr = wid >> 2, wc = wid & 3, fr = lane & 15, fq = lane >> 4;
    const int K = g.K, nt = K / BK, lda = g.lda;
    unsigned voffA[2], voffB[2];
#pragma unroll
    for (int i = 0; i < 2; ++i) { int R, C; stage_rc(tid * 16 + i * 8192, R, C); const int Rb = Epi::PERM ? ((R & ~31) + perm32(R & 31)) : R;
        voffA[i] = (unsigned)(R * lda + C) * 2u; voffB[i] = (unsigned)(Rb * K + C) * 2u; }
    const size_t kstep = (size_t)(BK * 2);
    const size_t hstepA = (size_t)HALF * lda * 2, hstepB = (size_t)HALF * K * 2;
    const size_t tstepA = 2 * hstepA, tstepB = 2 * hstepB;
    const unsigned ldsw = (unsigned)wid * 1024u;
    const int aoff = lds_byte(wr * 64 + fr, fq * 8), boff = lds_byte(wc * 32 + fr, fq * 8);
#define PG8_SA(b, h) (((b) * 2 + (h)) * HTB)
#define PG8_SB(b, h) ((4 + (b) * 2 + (h)) * HTB)
#define PG8_STAGE(bufoff, gbase, voff) do { _Pragma("unroll") for (int _i = 0; _i < 2; ++_i) \
        __builtin_amdgcn_global_load_lds((const unsigned*)((const char*)(gbase) + (voff)[_i]), (LAS unsigned*)(lds + (bufoff) + ldsw + _i * 8192), 16, 0, 0); } while (0)
#define PG8_LDA(dst, b, h) do { _Pragma("unroll") for (int m = 0; m < 4; ++m) _Pragma("unroll") for (int k = 0; k < 2; ++k) dst[m][k] = *(const LAS bf16x8*)(lds + PG8_SA(b, h) + aoff + m * 2048 + k * 1024); } while (0)
#define PG8_LDB(dst, b, h) do { _Pragma("unroll") for (int n = 0; n < 2; ++n) _Pragma("unroll") for (int k = 0; k < 2; ++k) dst[n][k] = *(const LAS bf16x8*)(lds + PG8_SB(b, h) + boff + n * 2048 + k * 1024); } while (0)
#define PG8_MMA(ai, bj, At, Bt) do { __builtin_amdgcn_s_setprio(1); _Pragma("unroll") for (int m = 0; m < 4; ++m) _Pragma("unroll") for (int n = 0; n < 2; ++n) _Pragma("unroll") for (int k = 0; k < 2; ++k) \
        acc[ai][bj][m][n] = __builtin_amdgcn_mfma_f32_16x16x32_bf16(Bt[n][k], At[m][k], acc[ai][bj][m][n], 0, 0, 0); __builtin_amdgcn_s_setprio(0); } while (0)
#define PG8_WAIT_V(n) asm volatile("s_waitcnt vmcnt(" #n ")" ::: "memory")
#define PG8_WAIT_L(n) asm volatile("s_waitcnt lgkmcnt(" #n ")" ::: "memory")
#define PG8_BAR __builtin_amdgcn_s_barrier()
#define PG8_SCHED __builtin_amdgcn_sched_barrier(0)
    Unit cur, nxt; int ui = 0;
    if (!S.next(0, cur)) return;
    f32x4 acc[2][2][4][2];
#pragma unroll
    for (int a = 0; a < 2; ++a)
#pragma unroll
        for (int b = 0; b < 2; ++b)
#pragma unroll
            for (int m = 0; m < 4; ++m)
#pragma unroll
                for (int n = 0; n < 2; ++n) acc[a][b][m][n] = (f32x4){0.f, 0.f, 0.f, 0.f};
    bf16x8 At[4][2], B0[2][2], B1[2][2];
    const char* cA = (const char*)g.A + (size_t)cur.pm * tstepA; const char* cB = (const char*)g.Bt + (size_t)cur.pn * tstepB;
    PG8_STAGE(PG8_SB(0, 0), cB, voffB); PG8_STAGE(PG8_SB(0, 1), cB + hstepB, voffB); PG8_STAGE(PG8_SA(0, 0), cA, voffA); PG8_STAGE(PG8_SA(0, 1), cA + hstepA, voffA);
    if (wr == 1) PG8_BAR;
    PG8_WAIT_V(2); PG8_BAR;
    PG8_STAGE(PG8_SB(1, 0), cB + kstep, voffB); PG8_STAGE(PG8_SA(1, 0), cA + kstep, voffA); PG8_STAGE(PG8_SB(1, 1), cB + hstepB + kstep, voffB);
    PG8_WAIT_V(6); PG8_BAR;
    for (;;) {
        const bool has_next = S.next(ui + 1, nxt);
        const char* nA = has_next ? (const char*)g.A + (size_t)nxt.pm * tstepA : cA; const char* nB = has_next ? (const char*)g.Bt + (size_t)nxt.pn * tstepB : cB;
        for (int t = 0; t < nt; t += 2) {
            const bool last = (t == nt - 2);
            const char* a1 = cA + (size_t)(t + 1) * kstep;
            const char* a2 = last ? nA : cA + (size_t)(t + 2) * kstep; const char* b2 = last ? nB : cB + (size_t)(t + 2) * kstep;
            const char* a3 = a2 + kstep; const char* b3 = b2 + kstep;
            PG8_LDB(B0, 0, 0); PG8_LDB(B1, 0, 1); PG8_SCHED; PG8_LDA(At, 0, 0); PG8_STAGE(PG8_SA(1, 1), a1 + hstepA, voffA);
            PG8_WAIT_V(8); PG8_WAIT_L(0); PG8_BAR; PG8_MMA(0, 0, At, B0); PG8_MMA(0, 1, At, B1); PG8_BAR; PG8_SCHED;
            PG8_LDA(At, 0, 1); PG8_STAGE(PG8_SB(0, 0), b2, voffB); PG8_STAGE(PG8_SB(0, 1), b2 + hstepB, voffB); PG8_STAGE(PG8_SA(0, 0), a2, voffA);
            PG8_WAIT_V(8); PG8_WAIT_L(0); PG8_BAR; PG8_MMA(1, 0, At, B0); PG8_MMA(1, 1, At, B1); PG8_BAR; PG8_SCHED;
            PG8_LDB(B0, 1, 0); PG8_LDB(B1, 1, 1); PG8_SCHED; PG8_LDA(At, 1, 0); PG8_STAGE(PG8_SA(0, 1), a2 + hstepA, voffA);
            PG8_WAIT_V(8); PG8_WAIT_L(0); PG8_BAR; PG8_MMA(0, 0, At, B0); PG8_MMA(0, 1, At, B1); PG8_BAR; PG8_SCHED;
            PG8_LDA(At, 1, 1); PG8_STAGE(PG8_SB(1, 0), b3, voffB); PG8_STAGE(PG8_SB(1, 1), b3 + hstepB, voffB); PG8_STAGE(PG8_SA(1, 0), a3, voffA);
            PG8_WAIT_V(8); PG8_WAIT_L(0); PG8_BAR; PG8_MMA(1, 0, At, B0); PG8_MMA(1, 1, At, B1); PG8_BAR; PG8_SCHED;
        }
        if constexpr (ALIGN_EPI) { if (wr == 0) PG8_BAR; }
        E(acc, cur, wr, wc, fr, fq);
        if (!has_next) break;
#pragma unroll
        for (int a = 0; a < 2; ++a)
#pragma unroll
            for (int b = 0; b < 2; ++b)
#pragma unroll
                for (int m = 0; m < 4; ++m)
#pragma unroll
                    for (int n = 0; n < 2; ++n) acc[a][b][m][n] = (f32x4){0.f, 0.f, 0.f, 0.f};
        cur = nxt; cA = nA; cB = nB; ++ui;
        if constexpr (ALIGN_EPI) { if (wr == 1) PG8_BAR; }
    }
    PG8_WAIT_V(0);
    if constexpr (!ALIGN_EPI) { if (wr == 0) PG8_BAR; }
    PG8_BAR;
#undef PG8_SA
#undef PG8_SB
#undef PG8_STAGE
#undef PG8_LDA
#undef PG8_LDB
#undef PG8_MMA
#undef PG8_WAIT_V
#undef PG8_WAIT_L
#undef PG8_BAR
#undef PG8_SCHED
}
}

namespace att {
typedef short v4i16_t __attribute__((ext_vector_type(4)));
__device__ __forceinline__ f32x16 mfma32(bf16x8 a, bf16x8 b, f32x16 c) { return __builtin_amdgcn_mfma_f32_32x32x16_bf16(a, b, c, 0, 0, 0); }
__device__ __forceinline__ s16x4 vtr(const LAS unsigned char* p) { return __builtin_bit_cast(s16x4, __builtin_amdgcn_ds_read_tr16_b64_v4i16((LAS v4i16_t*)p)); }

template <int DQK, int DK1, int DV, int MODE, bool QL = false>
__device__ __forceinline__ void flash_pass(LAS unsigned char* lds, const bf16_t* Q, int pitchQ, const bf16_t* K1, int pitchK1, const bf16_t* K2, int pitchK2,
                                           const bf16_t* V, int pitchV, int q0, float c2, float slope2, const f32x2* rope, f32x16 (&o)[DV / 32], float& l_out) {
    constexpr int PK = DQK * 2 + 16, PV = DV * 2 + 64, KB = 64 * PK, VB = 64 * PV, OFF_V = 2 * KB;
    constexpr int CPR1 = DK1 / 8, CPR2 = (DQK - DK1) / 8, CPRV = DV / 8, N1 = (64 * CPR1) / 512, NV = (64 * CPRV) / 512;
    constexpr int QOFF = 2 * KB + 2 * VB;
    static_assert(N1 >= 1 && NV >= 1 && QOFF + (QL ? 8 * 32 * PK : 0) <= LDS_CTRL, "tile geometry");
    const int tid = ltid(), lane = tid & 63, r32 = lane & 31, hi = lane >> 5, wid = __builtin_amdgcn_readfirstlane(tid >> 6);
    const int tq = q0 + 32 * wid + r32;
    bf16x8 qf[DQK / 16];
#pragma unroll
    for (int d0 = 0; d0 < DQK / 16; ++d0) qf[d0] = gld((const bf16x8*)(Q + (size_t)tq * pitchQ + 16 * d0 + 8 * hi));
    if constexpr (MODE == 2) {
        bf16x8 x1 = qf[4], x2 = qf[5];
#pragma unroll
        for (int e = 0; e < 8; e += 2) {
            const f32x2 cs0 = gld(rope + tq * 16 + 8 * hi + e), cs1 = gld(rope + tq * 16 + 8 * hi + e + 1);
            const float a0 = bf1((bf16_t)x1[e]), b0 = bf1((bf16_t)x2[e]), a1 = bf1((bf16_t)x1[e + 1]), b1 = bf1((bf16_t)x2[e + 1]);
            const unsigned w1 = cvt_pk_bf16(a0 * cs0.x - b0 * cs0.y, a1 * cs1.x - b1 * cs1.y), w2 = cvt_pk_bf16(a0 * cs0.y + b0 * cs0.x, a1 * cs1.y + b1 * cs1.x);
            x1[e] = (short)(w1 & 0xffff); x1[e + 1] = (short)(w1 >> 16); x2[e] = (short)(w2 & 0xffff); x2[e + 1] = (short)(w2 >> 16);
        }
        qf[4] = x1; qf[5] = x2;
    }
    LAS unsigned char* qaddr = lds + QOFF + (wid * 32 + r32) * PK + hi * 16;
    if constexpr (QL) {
#pragma unroll
        for (int d0 = 0; d0 < DQK / 16; ++d0) *(LAS bf16x8*)(qaddr + d0 * 32) = qf[d0];
    }
    constexpr bool D2 = true;
    u32x4 kregA[N1], kreg2A, vregA[NV], kregB[D2 ? N1 : 1], kreg2B, vregB[D2 ? NV : 1];
#define ATT_LOAD(R, t) do { \
        _Pragma("unroll") for (int i = 0; i < N1; ++i) { const int idx = tid + 512 * i, row = idx / CPR1, ch = idx % CPR1; kreg##R[i] = gld((const u32x4*)(K1 + (size_t)(64 * (t) + row) * pitchK1 + ch * 8)); } \
        if constexpr (CPR2 > 0) { if (tid < 64 * CPR2) { const int row = tid / (CPR2 > 0 ? CPR2 : 1), ch = tid % (CPR2 > 0 ? CPR2 : 1); kreg2##R = gld((const u32x4*)(K2 + (size_t)(64 * (t) + row) * pitchK2 + ch * 8)); } } \
        _Pragma("unroll") for (int i = 0; i < NV; ++i) { const int idx = tid + 512 * i, row = idx / CPRV, ch = idx % CPRV; vreg##R[i] = gld((const u32x4*)(V + (size_t)(64 * (t) + row) * pitchV + ch * 8)); } } while (0)
#define ATT_WRITE(R, buf) do { \
        _Pragma("unroll") for (int i = 0; i < N1; ++i) { const int idx = tid + 512 * i, row = idx / CPR1, ch = idx % CPR1; *(LAS u32x4*)(lds + (buf) * KB + row * PK + ch * 16) = kreg##R[i]; } \
        if constexpr (CPR2 > 0) { if (tid < 64 * CPR2) { const int row = tid / (CPR2 > 0 ? CPR2 : 1), ch = tid % (CPR2 > 0 ? CPR2 : 1); *(LAS u32x4*)(lds + (buf) * KB + row * PK + DK1 * 2 + ch * 16) = kreg2##R; } } \
        _Pragma("unroll") for (int i = 0; i < NV; ++i) { const int idx = tid + 512 * i, row = idx / CPRV, ch = idx % CPRV; *(LAS u32x4*)(lds + OFF_V + (buf) * VB + row * PV + ch * 16) = vreg##R[i]; } } while (0)
    const int NT = (q0 + 256) / 64, tlast = q0 / 64 + (wid >> 1);
    ATT_LOAD(A, NT - 1); ATT_WRITE(A, 0); if constexpr (D2) ATT_LOAD(A, NT - 2); __syncthreads();
    float m_run = 0.f, l_run = 0.f;
#pragma unroll
    for (int db = 0; db < DV / 32; ++db)
#pragma unroll
        for (int r = 0; r < 16; ++r) o[db][r] = 0.f;
    const int kfoff = r32 * PK + hi * 16;
    const int vfoff = (4 * hi + ((lane & 15) >> 2)) * PV + (16 * ((lane >> 4) & 1) + 4 * (lane & 3)) * 2;
#define ATT_TILE(MASKED, L, W) { \
        const int buf = (NT - 1 - t) & 1; \
        if constexpr (D2) { if (t > 1) ATT_LOAD(L, t - 2); } else { if (t > 0) ATT_LOAD(A, t - 1); } \
        if (t <= tlast) { \
            const bool first = (t == tlast); \
            const float mref = first ? 0.f : m_run; \
            const int dl0 = tq - 64 * t - 4 * hi; \
            const float sb0 = -slope2 * (float)dl0 - mref, sb1 = sb0 + 32.f * slope2; \
            f32x16 p0, p1; \
_Pragma("unroll") \
            for (int r = 0; r < 16; ++r) { const int cr_ = (r & 3) + 8 * (r >> 2); p0[r] = (MODE == 2) ? 0.f : __builtin_fmaf((float)cr_, slope2, sb0); p1[r] = (MODE == 2) ? 0.f : __builtin_fmaf((float)cr_, slope2, sb1); } \
            const LAS unsigned char* kb = lds + buf * KB + kfoff; \
            __builtin_amdgcn_s_setprio(1); \
_Pragma("unroll") \
            for (int d0 = 0; d0 < DQK / 16; ++d0) { \
                const bf16x8 k0 = *(const LAS bf16x8*)(kb + d0 * 32), k1 = *(const LAS bf16x8*)(kb + 32 * PK + d0 * 32); \
                bf16x8 qv; if constexpr (QL) qv = *(const LAS bf16x8*)(qaddr + d0 * 32); else qv = qf[d0]; \
                p0 = mfma32(k0, qv, p0); p1 = mfma32(k1, qv, p1); \
            } \
            __builtin_amdgcn_s_setprio(0); \
            if constexpr (MODE == 1) { \
                  \
                const int dmin = (q0 + 32 * wid) - (64 * t + 63), dmax = (q0 + 32 * wid + 31) - 64 * t; \
                const int tc = dmin > 512 ? 0 : ((dmin > 128 && dmax <= 512) ? 1 : ((dmin >= 0 && dmax <= 128) ? 2 : 3)); \
                if (tc == 0) { \
_Pragma("unroll") \
                    for (int r = 0; r < 16; ++r) { const int cr = (r & 3) + 8 * (r >> 2); const float bb = (((dl0 - cr) & 15) == 0) ? 0.f : -INFINITY; \
                        p0[r] += bb; p1[r] += bb; } \
                } else if (tc == 1) { \
_Pragma("unroll") \
                    for (int r = 0; r < 16; ++r) { const int cr = (r & 3) + 8 * (r >> 2), dlow = dl0 - cr; const float bb = ((dlow & 15) == 0) ? 1.0f : (((dlow & 3) == 0) ? 0.f : -INFINITY); \
                        p0[r] += bb; p1[r] += bb; } \
                } else if (tc == 2) { \
_Pragma("unroll") \
                    for (int r = 0; r < 16; ++r) { const int cr = (r & 3) + 8 * (r >> 2), dlow = dl0 - cr; const float bb = ((dlow & 15) == 0) ? 1.5849625007f : (((dlow & 3) == 0) ? 1.0f : 0.f); \
                        p0[r] += bb; p1[r] += bb; } \
                } else { \
_Pragma("unroll") \
                    for (int r = 0; r < 16; ++r) { \
                        const int cr = (r & 3) + 8 * (r >> 2); \
                        const int d0_ = dl0 - cr, d1_ = dl0 - 32 - cr; \
                        const bool a4 = (d0_ & 3) == 0, b16 = (d0_ & 15) == 0; \
                        const int n0 = ((unsigned)d0_ <= 128u ? 1 : 0) + ((a4 && ((unsigned)d0_ <= 512u)) ? 1 : 0) + ((b16 && d0_ >= 0) ? 1 : 0); \
                        const int n1 = ((unsigned)d1_ <= 128u ? 1 : 0) + ((a4 && ((unsigned)d1_ <= 512u)) ? 1 : 0) + ((b16 && d1_ >= 0) ? 1 : 0); \
                        const float b0 = n0 == 0 ? -INFINITY : (n0 == 1 ? 0.f : (n0 == 2 ? 1.0f : 1.5849625007f)); \
                        const float b1 = n1 == 0 ? -INFINITY : (n1 == 1 ? 0.f : (n1 == 2 ? 1.0f : 1.5849625007f)); \
                        p0[r] += b0; p1[r] += b1; \
                    } \
                } \
            } else { \
_Pragma("unroll") \
                for (int r = 0; r < 16; ++r) { \
                    const int cr = (r & 3) + 8 * (r >> 2); \
                    float s0, s1; \
                    if constexpr (MODE == 0) { s0 = p0[r]; s1 = p1[r]; } \
                    else { s0 = __builtin_fmaf(p0[r], c2, -mref); s1 = __builtin_fmaf(p1[r], c2, -mref); } \
                    if (MASKED) { if (cr > dl0) s0 = -INFINITY; if (cr > dl0 - 32) s1 = -INFINITY; } \
                    p0[r] = s0; p1[r] = s1; \
                } \
            } \
            float mx = fmaxf(p0[0], p1[0]); \
_Pragma("unroll") \
            for (int r = 1; r < 16; ++r) mx = fmaxf(mx, fmaxf(p0[r], p1[r])); \
            mx = fmaxf(mx, __shfl_xor(mx, 32)); \
            if (first || __any(mx > 8.0f)) { \
                const float delta = (first || mx > 8.0f) ? mx : 0.f; \
                const float alpha = __builtin_amdgcn_exp2f(-delta); \
                m_run = first ? mx : m_run + delta; \
                l_run *= alpha; \
_Pragma("unroll") \
                for (int r = 0; r < 16; ++r) { p0[r] -= delta; p1[r] -= delta; } \
_Pragma("unroll") \
                for (int db = 0; db < DV / 32; ++db) \
_Pragma("unroll") \
                    for (int r = 0; r < 16; ++r) o[db][r] *= alpha; \
            } \
            float ps = 0.f; \
_Pragma("unroll") \
            for (int r = 0; r < 16; ++r) { p0[r] = __builtin_amdgcn_exp2f(p0[r]); p1[r] = __builtin_amdgcn_exp2f(p1[r]); ps += p0[r] + p1[r]; } \
            l_run += ps; \
            bf16x8 pk[4]; \
            { u32x4 w; \
              w.x = cvt_pk_bf16(p0[0], p0[1]); w.y = cvt_pk_bf16(p0[2], p0[3]); w.z = cvt_pk_bf16(p0[4], p0[5]); w.w = cvt_pk_bf16(p0[6], p0[7]); pk[0] = __builtin_bit_cast(bf16x8, w); \
              w.x = cvt_pk_bf16(p0[8], p0[9]); w.y = cvt_pk_bf16(p0[10], p0[11]); w.z = cvt_pk_bf16(p0[12], p0[13]); w.w = cvt_pk_bf16(p0[14], p0[15]); pk[1] = __builtin_bit_cast(bf16x8, w); \
              w.x = cvt_pk_bf16(p1[0], p1[1]); w.y = cvt_pk_bf16(p1[2], p1[3]); w.z = cvt_pk_bf16(p1[4], p1[5]); w.w = cvt_pk_bf16(p1[6], p1[7]); pk[2] = __builtin_bit_cast(bf16x8, w); \
              w.x = cvt_pk_bf16(p1[8], p1[9]); w.y = cvt_pk_bf16(p1[10], p1[11]); w.z = cvt_pk_bf16(p1[12], p1[13]); w.w = cvt_pk_bf16(p1[14], p1[15]); pk[3] = __builtin_bit_cast(bf16x8, w); } \
            const LAS unsigned char* vb = lds + OFF_V + buf * VB + vfoff; \
s16x4 lo[2][DV / 32], hh[2][DV / 32]; \
            _Pragma("unroll") \
            for (int db = 0; db < DV / 32; ++db) { lo[0][db] = vtr(vb + 64 * db); hh[0][db] = vtr(vb + 8 * PV + 64 * db); } \
            _Pragma("unroll") \
            for (int ks = 0; ks < 4; ++ks) { \
                if (ks + 1 < 4) { \
                    _Pragma("unroll") \
                    for (int db = 0; db < DV / 32; ++db) { lo[(ks + 1) & 1][db] = vtr(vb + (16 * (ks + 1)) * PV + 64 * db); hh[(ks + 1) & 1][db] = vtr(vb + (16 * (ks + 1) + 8) * PV + 64 * db); } \
                } \
                __builtin_amdgcn_s_setprio(1); \
                _Pragma("unroll") \
                for (int db = 0; db < DV / 32; ++db) { \
                    const bf16x8 vf = (bf16x8){lo[ks & 1][db][0], lo[ks & 1][db][1], lo[ks & 1][db][2], lo[ks & 1][db][3], hh[ks & 1][db][0], hh[ks & 1][db][1], hh[ks & 1][db][2], hh[ks & 1][db][3]}; \
                    o[db] = mfma32(vf, pk[ks], o[db]); \
                } \
                __builtin_amdgcn_s_setprio(0); \
            } \
        } \
        if constexpr (D2) { if (t > 0) ATT_WRITE(W, buf ^ 1); } else { if (t > 0) ATT_WRITE(A, buf ^ 1); } \
        __syncthreads(); \
    }
    int t = NT - 1;
    { ATT_TILE(true, B, A) --t; ATT_TILE(true, A, B) --t; ATT_TILE(true, B, A) --t; ATT_TILE(true, A, B) --t; }
    for (; t >= 0; --t) { ATT_TILE(false, B, A) --t; ATT_TILE(false, A, B) --t; ATT_TILE(false, B, A) --t; ATT_TILE(false, A, B) }
#undef ATT_TILE
    l_out = l_run;
#undef ATT_LOAD
#undef ATT_WRITE
}

template <int DV>
__device__ __forceinline__ void store_o(LAS unsigned char* lds, bf16_t* O, int pitchO, int rowbase, int wave, int t2, const f32x16 (&o)[DV / 32], float sc) {
    constexpr int PO = DV * 2 + 16, CH = DV / 8;
    const int lane = t2 & 63, r32 = lane & 31, hi = lane >> 5;
    LAS unsigned char* st = lds + 75776 + wave * 8704;
#pragma unroll
    for (int db = 0; db < DV / 32; ++db)
#pragma unroll
        for (int g = 0; g < 4; ++g) {
            u32x2 w; w.x = cvt_pk_bf16(o[db][4 * g] * sc, o[db][4 * g + 1] * sc); w.y = cvt_pk_bf16(o[db][4 * g + 2] * sc, o[db][4 * g + 3] * sc);
            *(LAS u32x2*)(st + r32 * PO + 64 * db + 16 * g + 8 * hi) = w;
        }
#pragma unroll
    for (int i = 0; i < 32 * CH / 64; ++i) { const int id = lane + 64 * i, row = id / CH, ch = id % CH;
        const u32x4 v = *(const LAS u32x4*)(st + row * PO + ch * 16);
        gst((u32x4*)(O + (size_t)(rowbase + row) * pitchO + ch * 8), v); }
}
}

#define XB_TMO      128
#define XB_XCNT(j)  (256  + 64 * (j))
#define XB_XSUB(j)  (1280 + 64 * (j))
#define XB_XGEN(j)  (2304 + 64 * (j))
#define XB_TOP      3328
#define XB_TOPGEN   3392
#define XCD_BAR_WORDS 3456
#define XB_SPIN_CAP (1u << 18)

__device__ __forceinline__ unsigned xb_ld(unsigned* p)              { return __hip_atomic_load(p, __ATOMIC_RELAXED, __HIP_MEMORY_SCOPE_AGENT); }
__device__ __forceinline__ unsigned xb_add(unsigned* p, unsigned v) { return __hip_atomic_fetch_add(p, v, __ATOMIC_RELAXED, __HIP_MEMORY_SCOPE_AGENT); }
__device__ __forceinline__ unsigned xb_xcc_id() { return (unsigned)__builtin_amdgcn_s_getreg((3 << 11) | 20) & 0xFu; }
#define XB_SPIN(cond, bar) do { unsigned _sp = 0; while (cond) { __builtin_amdgcn_s_sleep(1); \
    if ((++_sp & 255u) == 0u) { if (xb_ld(&(bar)[XB_TMO])) break; if (_sp > XB_SPIN_CAP) { atomicAdd(&(bar)[XB_TMO], 1u); break; } } } } while (0)

struct XcdBarrier {
    unsigned* bar; unsigned x;
    volatile LAS unsigned* st;
};

__device__ __forceinline__ XcdBarrier xcd_barrier_post(unsigned* bar, volatile LAS unsigned* st) {
    XcdBarrier b; b.bar = bar; b.x = xb_xcc_id(); b.st = st;
    if (threadIdx.x == 0) (void)xb_add(&bar[XB_XCNT(b.x)], 1u);
    return b;
}
__device__ __forceinline__ void xcd_barrier_complete(unsigned* bar, unsigned x, unsigned& nloc, unsigned& nx) {
    const unsigned G = gridDim.x * gridDim.y * gridDim.z;
    unsigned sum, cnt, mine, sp = 0u;
    for (;;) {
        sum = 0u; cnt = 0u; mine = 0u;
#pragma unroll
        for (unsigned j = 0; j < 16; ++j) { const unsigned c = xb_ld(&bar[XB_XCNT(j)]); sum += c; cnt += (c > 0u) ? 1u : 0u; mine = (j == x) ? c : mine; }
        if (sum == G) break;
        __builtin_amdgcn_s_sleep(1);
        if ((++sp & 255u) == 0u) { if (xb_ld(&bar[XB_TMO])) break; if (sp > XB_SPIN_CAP) { atomicAdd(&bar[XB_TMO], 1u); break; } }
    }
    nloc = mine > 0u ? mine : 1u; nx = cnt > 0u ? cnt : 1u;
}

__device__ __forceinline__ void xcd_barrier(const XcdBarrier& b) {
    asm volatile("s_waitcnt vmcnt(0)" ::: "memory");
    __syncthreads();
    if (threadIdx.x == 0) {
        unsigned* bar = b.bar;
        __builtin_amdgcn_s_waitcnt(0);
        unsigned nloc = b.st[0], nx = b.st[1];
        if (nloc == 0u) { xcd_barrier_complete(bar, b.x, nloc, nx); b.st[0] = nloc; b.st[1] = nx; }
        const unsigned old = xb_add(&bar[XB_XSUB(b.x)], 1u);
        const unsigned gen = old / nloc;
        if (old + 1u == (gen + 1u) * nloc) {
            __builtin_amdgcn_fence(__ATOMIC_RELEASE, "agent");
            asm volatile("s_waitcnt vmcnt(0)" ::: "memory");
            const unsigned og = xb_add(&bar[XB_TOP], 1u);
            const unsigned tg = og / nx;
            if (og + 1u == (tg + 1u) * nx) xb_add(&bar[XB_TOPGEN], 1u);
            else XB_SPIN(xb_ld(&bar[XB_TOPGEN]) == tg, bar);
            __builtin_amdgcn_fence(__ATOMIC_ACQUIRE, "agent");
            xb_add(&bar[XB_XGEN(b.x)], 1u);
            asm volatile("s_waitcnt vmcnt(0)" ::: "memory");
        } else {
            XB_SPIN(xb_ld(&bar[XB_XGEN(b.x)]) == gen, bar);
            __builtin_amdgcn_fence(__ATOMIC_ACQUIRE, "agent");
            asm volatile("s_waitcnt vmcnt(0)" ::: "memory");
        }
    }
    __syncthreads();
}


struct Args { const float* in[18]; float* out; unsigned char* ws; int lo, hi, nchunk, pad; };

__device__ __forceinline__ int map_row(int n, int mode, int off) {
    if (mode == 0) return n + off;
    if (mode == 1) return n < 3744 ? n + 3072 : n - 3744;
    return 256 * (n >> 7) + 128 * (mode - 2) + (n & 127);
}
__device__ __forceinline__ void p0_transpose_item(const float* W, int K, int N, bf16_t* WT, int mode, LAS float* scr, int item, int lane, const float* gain = nullptr) {
    const int nblk = N / 32, kb = item / nblk, nb = item % nblk, k0 = 64 * kb, n0 = 32 * nb;
    f32x4 wv[8]; float gk[8];
#pragma unroll
    for (int i = 0; i < 8; ++i) { const int kk = 8 * i + (lane >> 3); wv[i] = gld((const f32x4*)(W + (size_t)(k0 + kk) * N + n0 + 4 * (lane & 7))); gk[i] = gain ? gld(gain + k0 + kk) : 1.0f; }
#pragma unroll
    for (int i = 0; i < 8; ++i) { const int kk = 8 * i + (lane >> 3); LAS float* d = scr + kk * 33 + 4 * (lane & 7); d[0] = wv[i].x * gk[i]; d[1] = wv[i].y * gk[i]; d[2] = wv[i].z * gk[i]; d[3] = wv[i].w * gk[i]; }
    asm volatile("s_waitcnt lgkmcnt(0)" ::: "memory");
    const int c = lane & 7;
#pragma unroll
    for (int j = 0; j < 4; ++j) { const int n = (lane >> 3) + 8 * j; const LAS float* s = scr + (8 * c) * 33 + n;
        u32x4 o; o.x = cvt_pk_bf16(s[0 * 33], s[1 * 33]); o.y = cvt_pk_bf16(s[2 * 33], s[3 * 33]); o.z = cvt_pk_bf16(s[4 * 33], s[5 * 33]); o.w = cvt_pk_bf16(s[6 * 33], s[7 * 33]);
        gst((u32x4*)(WT + (size_t)map_row(n0 + n, mode, 0) * K + k0 + 8 * c), o); }
    asm volatile("s_waitcnt lgkmcnt(0)" ::: "memory");
}

__device__ __forceinline__ void rms_row_to_bf16(const float* xrow, const float* gain, bf16_t* orow, int lane) {
    const f32x4* xr = (const f32x4*)xrow + lane; const f32x4* gr = (const f32x4*)gain + lane;
    f32x4 v[4]; float s = 0.f;
#pragma unroll
    for (int j = 0; j < 4; ++j) { v[j] = xr[64 * j]; s += (v[j].x * v[j].x + v[j].y * v[j].y) + (v[j].z * v[j].z + v[j].w * v[j].w); }
    const float rstd = __builtin_amdgcn_rsqf(wave_sum(s) * (1.f / DM) + NORM_EPS);
    u32x2* o8 = (u32x2*)orow + lane;
#pragma unroll
    for (int j = 0; j < 4; ++j) { const f32x4 g = gr[64 * j]; u32x2 w; w.x = cvt_pk_bf16(v[j].x * rstd * g.x, v[j].y * rstd * g.y); w.y = cvt_pk_bf16(v[j].z * rstd * g.z, v[j].w * rstd * g.w); o8[64 * j] = w; }
}

#define INPTR(k) ({ int _i = (k); asm volatile("" : "+s"(_i)); (const float*)(GAS const float*)a.in[_i]; })
__global__ void __launch_bounds__(512, 2) mega(Args a) {
    extern __shared__ __attribute__((aligned(16))) unsigned char lds_raw[];
    LAS unsigned char* lds = (LAS unsigned char*)lds_raw;
    cg::grid_group grid = cg::this_grid();
    const int G = gridDim.x, NGW = G * 8;
    const int nchunk = a.nchunk, NB = NBATCH / nchunk;
    if (threadIdx.x < 8) ((LAS unsigned*)(lds + LDS_CTRL))[threadIdx.x] = 0u;
    __syncthreads();
    const XcdBarrier xbar = xcd_barrier_post((unsigned*)(a.ws + WS_CTL) + 8192, (volatile LAS unsigned*)(lds + LDS_CTRL + 16));

    for (int step = a.lo; step < a.hi; ++step) {
        const int tid = ltid(), lane = tid & 63, wave = __builtin_amdgcn_readfirstlane(tid >> 6), gw = blockIdx.x * 8 + wave;
        unsigned char* ws = a.ws; int Tc = TTOK / nchunk;
        asm volatile("" : "+s"(ws), "+s"(Tc));
        ws = (unsigned char*)(GAS unsigned char*)ws;
        unsigned* ctl = (unsigned*)(ws + WS_CTL);
        f32x2* rope = (f32x2*)(ws + WS_ROPE);
        bf16_t* XN = (bf16_t*)(ws + WS_ACT);
        bf16_t* PROJ = XN + (size_t)Tc * 1024;
        bf16_t* QC = PROJ + (size_t)Tc * INP;
        bf16_t* KVC = QC + (size_t)Tc * 768;
        bf16_t* OC = KVC + (size_t)Tc * 1024;
        bf16_t* MIX = OC + (size_t)Tc * 512;
        bf16_t* OA = MIX + (size_t)Tc * 1024;
        bf16_t* OB = OA + (size_t)Tc * 512;
        float* PART = (float*)(OB + (size_t)Tc * 512);
        bf16_t* UB = PROJ;
        const float* x_in = INPTR(0);
        float* X = (float*)(GAS float*)a.out;
        if (step == 0 && EN(10)) {
            LAS float* scr = (LAS float*)(lds + wave * 16384);
            constexpr int I_IN = 16 * 213, I_UQ = 6 * 24, I_UKV = 4 * 32, I_BR = 8 * 32, I_OUT = 16 * 32, I_G = 16 * 88, I_D = 44 * 32;
            constexpr int I_L = I_IN + I_UQ + I_UKV + 3 * I_BR + I_OUT + 2 * I_G + I_D;
            for (int prep_ = 0; prep_ < (DUP == 10 ? 2 : 1); ++prep_)
            for (int it = gw; it < 2 * I_L; it += NGW) {
                const int l = it / I_L; int r = it % I_L;
                bf16_t* LW = (bf16_t*)(ws + WS_W) + (size_t)l * LW_TOTAL;
                if (r < I_IN) { p0_transpose_item(INPTR(2) + (size_t)l * 1024 * INW, 1024, INW, LW + LW_IN, 1, scr, r, lane, INPTR(1) + (size_t)l * DM); continue; } r -= I_IN;
                if (r < I_UQ) { p0_transpose_item(INPTR(6) + (size_t)l * 384 * 768, 384, 768, LW + LW_UQ, 0, scr, r, lane); continue; } r -= I_UQ;
                if (r < I_UKV) { p0_transpose_item(INPTR(8) + (size_t)l * 256 * 1024, 256, 1024, LW + LW_UKV, 0, scr, r, lane); continue; } r -= I_UKV;
                if (r < I_BR) { p0_transpose_item(INPTR(9) + (size_t)l * 512 * 1024, 512, 1024, LW + LW_A, 0, scr, r, lane); continue; } r -= I_BR;
                if (r < I_BR) { p0_transpose_item(INPTR(10) + (size_t)l * 512 * 1024, 512, 1024, LW + LW_B, 0, scr, r, lane); continue; } r -= I_BR;
                if (r < I_BR) { p0_transpose_item(INPTR(11) + (size_t)l * 512 * 1024, 512, 1024, LW + LW_C, 0, scr, r, lane); continue; } r -= I_BR;
                if (r < I_OUT) { p0_transpose_item(INPTR(12) + (size_t)l * 1024 * 1024, 1024, 1024, LW + LW_OUT, 0, scr, r, lane); continue; } r -= I_OUT;
                if (r < I_G) { p0_transpose_item(INPTR(14) + (size_t)l * 1024 * FF, 1024, FF, LW + LW_GU, 2, scr, r, lane, INPTR(13) + (size_t)l * DM); continue; } r -= I_G;
                if (r < I_G) { p0_transpose_item(INPTR(15) + (size_t)l * 1024 * FF, 1024, FF, LW + LW_GU, 3, scr, r, lane, INPTR(13) + (size_t)l * DM); continue; } r -= I_G;
                p0_transpose_item(INPTR(16) + (size_t)l * FF * 1024, FF, 1024, LW + LW_D, 0, scr, r, lane);
            }
            for (int i = blockIdx.x * 512 + tid; i < 2 * 12288; i += G * 512) { const int l = i / 12288, c = i % 12288;
                *(u32x4*)((bf16_t*)(ws + WS_W) + (size_t)l * LW_TOTAL + LW_IN + (size_t)INW * 1024 + (size_t)c * 8) = (u32x4){0u, 0u, 0u, 0u}; }
            for (int i = blockIdx.x * 512 + tid; i < SEQ * 16; i += G * 512) { const int pos = i >> 4, k = i & 15;
                const float invf = __builtin_amdgcn_exp2f(-(float)k * 0.8304820237218406f);
                const float ang = (float)pos * invf;
                const double rev = (double)ang * 0.15915494309189535; const float fr = (float)(rev - __builtin_floor(rev));
                rope[i] = (f32x2){__builtin_amdgcn_cosf(fr), __builtin_amdgcn_sinf(fr)}; }
            __syncthreads();
        } else if (((step - 1) % (2 * ((DUP >= 0) ? 11 : 10) + 1)) == 2 * ((DUP >= 0) ? 11 : 10) && EN(11)) {
            const int fck = (step - 1) / (2 * ((DUP >= 0) ? 11 : 10) + 1); const size_t frow0 = (size_t)fck * Tc;
            const float* gain = INPTR(17);
            f32x4 gv[4];
#pragma unroll
            for (int j = 0; j < 4; ++j) gv[j] = gld((const f32x4*)gain + lane + 64 * j);
            for (int m0 = gw * 2; m0 < Tc; m0 += NGW * 2) {
                f32x4 v[2][4];
#pragma unroll
                for (int rr = 0; rr < 2; ++rr) { const f32x4* xr = (const f32x4*)(X + (frow0 + m0 + rr) * DM) + lane;
#pragma unroll
                    for (int j = 0; j < 4; ++j) v[rr][j] = gld(xr + 64 * j); }
#pragma unroll
                for (int rr = 0; rr < 2; ++rr) { f32x4* xr = (f32x4*)(X + (frow0 + m0 + rr) * DM) + lane; float sq = 0.f;
#pragma unroll
                    for (int j = 0; j < 4; ++j) sq += (v[rr][j].x * v[rr][j].x + v[rr][j].y * v[rr][j].y) + (v[rr][j].z * v[rr][j].z + v[rr][j].w * v[rr][j].w);
                    const float rstd = __builtin_amdgcn_rsqf(wave_sum(sq) * (1.f / DM) + NORM_EPS);
#pragma unroll
                    for (int j = 0; j < 4; ++j) gst(xr + 64 * j, v[rr][j] * rstd * gv[j]); }
            }
        } else {
            constexpr int SPL = (DUP >= 0) ? 11 : 10;
            const int s0 = step - 1, ck = s0 / (2 * SPL + 1), rch = s0 % (2 * SPL + 1), l = rch / SPL, idx = rch % SPL, sp = (DUP >= 0 && idx > DUP) ? idx - 1 : idx, rep = (DUP >= 0 && idx == DUP + 1) ? 1 : 0;
            {
            const size_t trow0 = (size_t)ck * Tc;
            const bf16_t* LW = (const bf16_t*)(ws + WS_W) + (size_t)l * LW_TOTAL;
            const float* xcur = (l == 0) ? x_in : X;
            if (sp == 7 || (sp == 0 && l == 1) || (rep && sp == 6 && l == 1)) continue;
            if (sp == 0 && EN(0)) {
                for (int m0 = gw * 2; m0 < Tc; m0 += NGW * 2) {
                    f32x4 v[2][4];
#pragma unroll
                    for (int rr = 0; rr < 2; ++rr) { const f32x4* xr = (const f32x4*)(x_in + (trow0 + m0 + rr) * DM) + lane;
#pragma unroll
                        for (int j = 0; j < 4; ++j) v[rr][j] = gld(xr + 64 * j); }
#pragma unroll
                    for (int rr = 0; rr < 2; ++rr) { const int m = m0 + rr; u32x2* o8 = (u32x2*)(XN + (size_t)m * 1024) + lane; float ssq = 0.f;
#pragma unroll
                        for (int j = 0; j < 4; ++j) { const f32x4 x = v[rr][j]; ssq += (x.x * x.x + x.y * x.y) + (x.z * x.z + x.w * x.w); u32x2 w; w.x = cvt_pk_bf16(x.x, x.y); w.y = cvt_pk_bf16(x.z, x.w); gst(o8 + 64 * j, w); }
                        ssq = wave_sum(ssq);
                        if (lane < 16) gst(PART + (size_t)m * 16 + lane, lane == 0 ? ssq : 0.f); }
                }
            } else if (sp == 2 && EN(2)) {
                const float* gq = INPTR(5) + (size_t)l * 384; const float* gkv = INPTR(7) + (size_t)l * 256;
                for (int m0 = gw * 2; m0 < Tc; m0 += NGW * 2) {
                    u32x4 wq[2], wk[2]; float x1[2], x2[2]; f32x2 cs[2];
#pragma unroll
                    for (int rr = 0; rr < 2; ++rr) { const int m = m0 + rr; bf16_t* P = PROJ + (size_t)m * INP;
                        wq[rr] = (u32x4){0u, 0u, 0u, 0u}; wk[rr] = (u32x4){0u, 0u, 0u, 0u}; x1[rr] = 0.f; x2[rr] = 0.f; cs[rr] = (f32x2){0.f, 0.f};
                        if (lane < 48) wq[rr] = *(const u32x4*)(P + C_CQ + lane * 8);
                        if (lane < 32) wk[rr] = *(const u32x4*)(P + C_CKV + lane * 8);
                        if (lane < 16) { x1[rr] = bf1(P[C_KPE + lane]); x2[rr] = bf1(P[C_KPE + 16 + lane]); cs[rr] = rope[(m & (SEQ - 1)) * 16 + lane]; } }
#pragma unroll
                    for (int rr = 0; rr < 2; ++rr) { const int m = m0 + rr; bf16_t* P = PROJ + (size_t)m * INP;
                        { const u32x4 w = wq[rr];
                          float ss = bf_lo(w.x) * bf_lo(w.x) + bf_hi(w.x) * bf_hi(w.x) + bf_lo(w.y) * bf_lo(w.y) + bf_hi(w.y) * bf_hi(w.y) + bf_lo(w.z) * bf_lo(w.z) + bf_hi(w.z) * bf_hi(w.z) + bf_lo(w.w) * bf_lo(w.w) + bf_hi(w.w) * bf_hi(w.w);
                          const float rstd = __builtin_amdgcn_rsqf(wave_sum(ss) * (1.f / 384.f) + NORM_EPS);
                          if (lane < 48) { const f32x4 g0 = *(const f32x4*)(gq + lane * 8), g1 = *(const f32x4*)(gq + lane * 8 + 4); u32x4 o;
                              o.x = cvt_pk_bf16(bf_lo(w.x) * rstd * g0.x, bf_hi(w.x) * rstd * g0.y); o.y = cvt_pk_bf16(bf_lo(w.y) * rstd * g0.z, bf_hi(w.y) * rstd * g0.w);
                              o.z = cvt_pk_bf16(bf_lo(w.z) * rstd * g1.x, bf_hi(w.z) * rstd * g1.y); o.w = cvt_pk_bf16(bf_lo(w.w) * rstd * g1.z, bf_hi(w.w) * rstd * g1.w);
                              *(u32x4*)(P + C_CQ + lane * 8) = o; } }
                        { const u32x4 w = wk[rr];
                          float ss = bf_lo(w.x) * bf_lo(w.x) + bf_hi(w.x) * bf_hi(w.x) + bf_lo(w.y) * bf_lo(w.y) + bf_hi(w.y) * bf_hi(w.y) + bf_lo(w.z) * bf_lo(w.z) + bf_hi(w.z) * bf_hi(w.z) + bf_lo(w.w) * bf_lo(w.w) + bf_hi(w.w) * bf_hi(w.w);
                          const float rstd = __builtin_amdgcn_rsqf(wave_sum(ss) * (1.f / 256.f) + NORM_EPS);
                          if (lane < 32) { const f32x4 g0 = *(const f32x4*)(gkv + lane * 8), g1 = *(const f32x4*)(gkv + lane * 8 + 4); u32x4 o;
                              o.x = cvt_pk_bf16(bf_lo(w.x) * rstd * g0.x, bf_hi(w.x) * rstd * g0.y); o.y = cvt_pk_bf16(bf_lo(w.y) * rstd * g0.z, bf_hi(w.y) * rstd * g0.w);
                              o.z = cvt_pk_bf16(bf_lo(w.z) * rstd * g1.x, bf_hi(w.z) * rstd * g1.y); o.w = cvt_pk_bf16(bf_lo(w.w) * rstd * g1.z, bf_hi(w.w) * rstd * g1.w);
                              *(u32x4*)(P + C_CKV + lane * 8) = o; } }
                        if (lane < 16) { const unsigned w = cvt_pk_bf16(x1[rr] * cs[rr].x - x2[rr] * cs[rr].y, x1[rr] * cs[rr].y + x2[rr] * cs[rr].x);
                            P[C_KPE + lane] = (bf16_t)(w & 0xffff); P[C_KPE + 16 + lane] = (bf16_t)(w >> 16); }
                    }
                }
            } else if (sp == 4 && EN(4)) {
                unsigned* ctr = ctl + 64 * (1 + ck * 2 + l + 64 * rep);
                LAS int* s_unit = (LAS int*)(lds + LDS_CTRL);
                const float lam_init = (l == 0) ? 0.2f : 0.35550906f;
                float lam;
                { const float* lf = INPTR(3) + (size_t)l * 256; const float sa = wave_sum(lf[lane] * lf[64 + lane]), sb = wave_sum(lf[128 + lane] * lf[192 + lane]); lam = __expf(sa) - __expf(sb) + lam_init; lam = __uint_as_float(__builtin_amdgcn_readfirstlane(__float_as_uint(lam))); }
                const float* dgain = INPTR(4) + (size_t)l * 128;
                const int per_j = 16 * NB, nunits = 8 * per_j;
                for (;;) {
                    if (tid == 0) *s_unit = (int)atomicAdd(ctr, 1u);
                    __syncthreads();
                    const int u = *s_unit;
                    __syncthreads();
                    if (u >= nunits) break;
                    const int j = 7 - u / per_j, v = u % per_j, q0 = 256 * j;
                    if (PROBE_MIX >= 0 && rep) { const int mixer_ = v < 4 * NB ? 0 : (v < 8 * NB ? 1 : 2); if (mixer_ != PROBE_MIX) continue; }
                    const int t2 = ltid(), r32 = t2 & 31, hi = (t2 >> 5) & 1, tq = q0 + 32 * wave + r32;
                    if (v < 4 * NB) {
#ifndef NO_A
                        const int b = v >> 2, h = v & 3; bf16_t* base = PROJ + (size_t)b * SEQ * INP;
                        const float slope2 = __builtin_amdgcn_exp2f(-(float)(2 * h + 1)) * LOG2E, c2 = 0.125f * LOG2E;
                        f32x16 o1[4]; float l0, l1; unsigned o0p[4][8];
                        att::flash_pass<64, 64, 128, 0>(lds, base + C_AQ + h * 128, INP, base + C_AK + h * 128, INP, nullptr, 0, base + C_AV + h * 128, INP, q0, c2, slope2, nullptr, o1, l0);
                        l0 += __shfl_xor(l0, 32); { const float il = 1.0f / l0;
#pragma unroll
                            for (int db = 0; db < 4; ++db)
#pragma unroll
                                for (int r = 0; r < 16; r += 2) o0p[db][r >> 1] = cvt_pk_bf16(o1[db][r] * il, o1[db][r + 1] * il); }
                        att::flash_pass<64, 64, 128, 0>(lds, base + C_AQ + h * 128 + 64, INP, base + C_AK + h * 128 + 64, INP, nullptr, 0, base + C_AV + h * 128, INP, q0, c2, slope2, nullptr, o1, l1);
                        l1 += __shfl_xor(l1, 32); const float il1 = lam / l1; float ss = 0.f;
#pragma unroll
                        for (int db = 0; db < 4; ++db)
#pragma unroll
                            for (int r = 0; r < 16; r += 2) { const float d0 = bf_lo(o0p[db][r >> 1]) - il1 * o1[db][r], d1 = bf_hi(o0p[db][r >> 1]) - il1 * o1[db][r + 1]; o1[db][r] = d0; o1[db][r + 1] = d1; ss += d0 * d0 + d1 * d1; }
                        ss += __shfl_xor(ss, 32);
                        const float rstd = __builtin_amdgcn_rsqf(ss * (1.f / 128.f) + NORM_EPS) * (1.0f - lam_init);
#pragma unroll
                        for (int db = 0; db < 4; ++db)
#pragma unroll
                            for (int g = 0; g < 4; ++g) { const f32x4 gg = gld((const f32x4*)(dgain + 32 * db + 8 * g + 4 * hi));
#pragma unroll
                                for (int e = 0; e < 4; ++e) o1[db][4 * g + e] *= gg[e]; }
                        att::store_o<128>(lds, OA + (size_t)b * SEQ * 512 + h * 128, 512, q0 + 32 * wave, wave, t2, o1, rstd);
#endif
                    } else if (v < 8 * NB) {
#ifndef NO_B
                        const int vv = v - 4 * NB, b = vv >> 2, h = vv & 3; bf16_t* base = PROJ + (size_t)b * SEQ * INP;
                        const float slope2 = __builtin_amdgcn_exp2f(-(float)(2 * h + 2)) * LOG2E, c2 = 0.08838834764831845f * LOG2E;
                        f32x16 o[4]; float ll;
                        att::flash_pass<128, 128, 128, 1, true>(lds, base + C_BQ + h * 128, INP, base + C_BK + h * 128, INP, nullptr, 0, base + C_BV + h * 128, INP, q0, c2, slope2, nullptr, o, ll);
                        ll += __shfl_xor(ll, 32);
                        att::store_o<128>(lds, OB + (size_t)b * SEQ * 512 + h * 128, 512, q0 + 32 * wave, wave, t2, o, 1.0f / ll);
#endif
                    } else {
#ifndef NO_C
                        const int vv = v - 8 * NB, b = vv >> 3, h = vv & 7; const size_t r0 = (size_t)b * SEQ;
                        const float c2 = 0.10206207261596575f * LOG2E;
                        f32x16 o[2]; float ll;
                        att::flash_pass<96, 64, 64, 2>(lds, QC + r0 * 768 + h * 96, 768, KVC + r0 * 1024 + h * 128, 1024, PROJ + r0 * INP + C_KPE, INP, KVC + r0 * 1024 + h * 128 + 64, 1024, q0, c2, 0.f, rope, o, ll);
                        ll += __shfl_xor(ll, 32);
                        att::store_o<64>(lds, OC + r0 * 512 + h * 64, 512, q0 + 32 * wave, wave, t2, o, 1.0f / ll);
#endif
                    }
                }
            } else {
                const int nsub = (sp == 3) ? 2 : (sp == 5 ? 3 : 1);
                for (int sub = 0; sub < nsub; ++sub) {
                    pg8::Gemm g; pg8::StaticOrder S;
                    if (sp == 1 && EN(1)) { g = pg8::Gemm{XN, 1024, LW + LW_IN, Tc, INP, 1024}; S.init(Tc, INP, G, (int)blockIdx.x);
                        pg8::EpiStore E{PROJ, INP, 12, PART, 1}; pg8::gemm_phase<pg8::EpiStore, true>(lds, g, S, E); }
                    else if (sp == 3 && EN(3)) {
                        pg8::EpiStore E;
                        if (sub == 0) { g = pg8::Gemm{PROJ + C_CKV, INP, LW + LW_UKV, Tc, 1024, 256}; E = pg8::EpiStore{KVC, 1024, 0, nullptr, 0}; }
                        else { g = pg8::Gemm{PROJ + C_CQ, INP, LW + LW_UQ, Tc, 768, 384}; E = pg8::EpiStore{QC, 768, 0, nullptr, 0}; }
                        S.init(Tc, g.N, G, (int)blockIdx.x);
                        pg8::gemm_phase<pg8::EpiStore, true>(lds, g, S, E); }
                    else if (sp == 5 && EN(5)) {
                        S.init(Tc, 1024, G, (int)blockIdx.x);
                        if (sub == 0) g = pg8::Gemm{OA, 512, LW + LW_A, Tc, 1024, 512};
                        else if (sub == 1) g = pg8::Gemm{OB, 512, LW + LW_B, Tc, 1024, 512};
                        else g = pg8::Gemm{OC, 512, LW + LW_C, Tc, 1024, 512};
                        pg8::EpiGate E{PROJ + C_GATE + 1024 * sub, INP, MIX, 1024, sub == 0 ? 1 : 0};
                        pg8::gemm_phase<pg8::EpiGate, true>(lds, g, S, E); }
                    else if ((sp == 6 || sp == 9) && EN(6)) {
                        S.init(Tc, 1024, G, (int)blockIdx.x);
                        if (sp == 6) g = pg8::Gemm{MIX, 1024, LW + LW_OUT, Tc, 1024, 1024}; else g = pg8::Gemm{UB, FF, LW + LW_D, Tc, 1024, FF};
                        pg8::EpiResid E{(sp == 6 ? xcur : X) + trow0 * DM, rep ? (float*)(PART + (size_t)Tc * 16) : X + trow0 * DM, (sp == 9 && l == 1) ? (bf16_t*)nullptr : XN, PART};
                        pg8::gemm_phase<pg8::EpiResid, true>(lds, g, S, E); }
                    else if (sp == 8 && EN(8)) { g = pg8::Gemm{XN, 1024, LW + LW_GU, Tc, 2 * FF, 1024}; S.init(Tc, 2 * FF, G, (int)blockIdx.x);
                        pg8::EpiSwiGLU E{UB, FF, PART}; pg8::gemm_phase<pg8::EpiSwiGLU, true>(lds, g, S, E); }
                }
            }
            }
        }
        if (step + 1 < a.hi) { if (step == 0) grid.sync(); else xcd_barrier(xbar); }
    }
}

extern "C" void kernel_launch(void* const* d_in, const int* in_sizes, int n_in, void* d_out, int out_size, void* d_ws, size_t ws_size, hipStream_t stream) {
    static int grid = 0, nchunk = 0;
    if (grid == 0) {
        int dev = 0, cus = 0, per_cu = 0;
        if (hipGetDevice(&dev) != hipSuccess || hipDeviceGetAttribute(&cus, hipDeviceAttributeMultiprocessorCount, dev) != hipSuccess) { fprintf(stderr, "kernel_launch: device query failed\n"); grid = -1; return; }
        if (hipFuncSetAttribute((const void*)mega, hipFuncAttributeMaxDynamicSharedMemorySize, LDS_BYTES) != hipSuccess) { fprintf(stderr, "kernel_launch: hipFuncSetAttribute failed\n"); grid = -1; return; }
        if (hipOccupancyMaxActiveBlocksPerMultiprocessor(&per_cu, (const void*)mega, 512, LDS_BYTES) != hipSuccess || per_cu < 1) { fprintf(stderr, "kernel_launch: occupancy query says %d\n", per_cu); per_cu = 1; }
        (void)hipGetLastError();
        grid = cus;
        nchunk = 2;
        while (nchunk < 32 && WS_ACT + (size_t)(TTOK / nchunk) * ACT_COLS * 2 > ws_size) nchunk *= 2;
        if (n_in != 18 || out_size != TTOK * DM) { fprintf(stderr, "kernel_launch: unexpected shapes\n"); grid = -1; return; }
    }
    if (grid < 0) return;
    (void)hipMemsetAsync((char*)d_ws + WS_CTL, 0, 65536, stream);
    Args a{};
    for (int i = 0; i < 18; ++i) a.in[i] = (const float*)d_in[i];
    a.out = (float*)d_out; a.ws = (unsigned char*)d_ws; a.nchunk = nchunk; a.pad = 0;
    const int nsteps = 1 + nchunk * (2 * ((DUP >= 0) ? 11 : 10) + 1);
#if ONE_LAUNCH
    a.lo = 0; a.hi = nsteps;
    void* args[] = {&a};
    hipError_t e = hipLaunchCooperativeKernel((const void*)mega, dim3(grid), dim3(512), args, LDS_BYTES, stream);
    if (e != hipSuccess) fprintf(stderr, "cooperative launch failed: %s (grid %d)\n", hipGetErrorString(e), grid);
#else
    for (int s = 0; s < nsteps; ++s) { a.lo = s; a.hi = s + 1; hipLaunchKernelGGL(mega, dim3(grid), dim3(512), LDS_BYTES, stream, a); }
#endif
}
```

```cpp
#include <hip/hip_runtime.h>
#include <hip/hip_cooperative_groups.h>
#include <cstdio>
#include <cstdint>
namespace cg = cooperative_groups;

#ifndef ONE_LAUNCH
#define ONE_LAUNCH 1
#endif

#ifndef PROBE_MIX
#define PROBE_MIX -1
#endif
#ifndef DUP
#define DUP -1
#endif
#ifndef DIS
#define DIS 0
#endif
#define EN(k) (!((DIS >> (k)) & 1))
#define LAS __attribute__((address_space(3)))
#define GAS __attribute__((address_space(1)))
typedef unsigned short bf16_t;
typedef short bf16x8 __attribute__((ext_vector_type(8)));
typedef short s16x4 __attribute__((ext_vector_type(4)));
typedef float f32x4 __attribute__((ext_vector_type(4)));
typedef float f32x2 __attribute__((ext_vector_type(2)));
typedef float f32x16 __attribute__((ext_vector_type(16)));
typedef unsigned u32x4 __attribute__((ext_vector_type(4)));
typedef unsigned u32x2 __attribute__((ext_vector_type(2)));

constexpr int DM = 1024, SEQ = 2048, NBATCH = 32, TTOK = NBATCH * SEQ, INW = 6816, INP = 6912, FF = 2816;
constexpr int C_GATE = 0, C_AQ = 3072, C_AK = 3584, C_AV = 4096, C_BQ = 4608, C_BK = 5120, C_BV = 5632, C_CQ = 6144, C_CKV = 6528, C_KPE = 6784;
constexpr float NORM_EPS = 1e-6f;
constexpr float LOG2E = 1.4426950408889634f;
constexpr size_t LW_IN = 0, LW_UQ = LW_IN + (size_t)INP * 1024, LW_UKV = LW_UQ + 768 * 384, LW_A = LW_UKV + 1024 * 256, LW_B = LW_A + 1024 * 512,
                 LW_C = LW_B + 1024 * 512, LW_OUT = LW_C + 1024 * 512, LW_GU = LW_OUT + 1024 * 1024, LW_D = LW_GU + (size_t)5632 * 1024, LW_TOTAL = LW_D + (size_t)1024 * FF;
constexpr size_t MiB = 1u << 20;
constexpr size_t WS_CTL = 0, WS_ROPE = 1 * MiB, WS_W = 2 * MiB, WS_ACT = 80 * MiB;
static_assert(WS_W + 2 * LW_TOTAL * 2 <= WS_ACT, "weights fit");
constexpr size_t ACT_COLS = 1024 + INP + 768 + 1024 + 512 + 1024 + 1024 + 32;
constexpr int LDS_CTRL = 147456, LDS_BYTES = LDS_CTRL + 256;

template <class T> __device__ __forceinline__ T gld(const T* p) { return *(const GAS T*)p; }
template <class T> __device__ __forceinline__ void gst(T* p, T v) { *(GAS T*)p = v; }
__device__ __forceinline__ unsigned cvt_pk_bf16(float lo, float hi) { unsigned r; asm volatile("v_cvt_pk_bf16_f32 %0, %1, %2" : "=v"(r) : "v"(lo), "v"(hi)); return r; }
__device__ __forceinline__ float bf_lo(unsigned w) { return __uint_as_float(w << 16); }
__device__ __forceinline__ float bf_hi(unsigned w) { return __uint_as_float(w & 0xffff0000u); }
__device__ __forceinline__ float bf1(bf16_t h) { return __uint_as_float(((unsigned)h) << 16); }
__device__ __forceinline__ float fsigmoid(float x) { return __builtin_amdgcn_rcpf(1.0f + __builtin_amdgcn_exp2f(-x * LOG2E)); }
__device__ __forceinline__ int ltid() { int t = threadIdx.x; asm volatile("" : "+v"(t)); return t; }
__device__ __forceinline__ float wave_sum(float v) {
#pragma unroll
    for (int o = 1; o < 64; o <<= 1) v += __shfl_xor(v, o);
    return v;
}

namespace pg8 {
constexpr int BM = 256, BK = 64, HALF = 128, HTB = HALF * BK * 2, STAGE_BYTES = 8 * HTB, NXCD = 8, WGM = 8;
__host__ __device__ __forceinline__ int lds_byte(int r, int c) { const int st = (r >> 4) * 2 + (c >> 5), rr = r & 15, cc = c & 31, ob = rr * 64 + cc * 2; return st * 1024 + (ob ^ (((ob >> 9) & 1) << 5)); }
__host__ __device__ __forceinline__ void stage_rc(int b, int& R, int& C) { const int st = b / 1024, sb = b % 1024, swz = sb ^ (((sb >> 9) & 1) << 5); R = (st >> 1) * 16 + swz / 64; C = (st & 1) * 32 + (swz % 64) / 2; }
__host__ __device__ __forceinline__ int perm32(int rho) { const int n = rho >> 4, i = rho & 15; return 8 * (i >> 2) + 4 * n + (i & 3); }
struct Unit { int pm, pn; };
struct Gemm { const bf16_t* A; int lda; const bf16_t* Bt; int M, N, K; };
struct StaticOrder {
    int nM, nN, nwg, G, c;
    __device__ void init(int M, int N, int G_, int c_) { nM = M / BM; nN = N / BM; nwg = nM * nN; G = G_; c = c_; }
    __device__ bool next(int i, Unit& u) const {
        const long L = (long)i * G + c; if (L >= nwg) return false;
        int wgid = (int)L; { const int q = nwg / NXCD, r = nwg % NXCD, xcd = wgid % NXCD, off = wgid / NXCD; wgid = (xcd < r ? xcd * (q + 1) : r * (q + 1) + (xcd - r) * q) + off; }
        const int nig = WGM * nN, gid = wgid / nig, fm = gid * WGM, gsz = (nM - fm) < WGM ? (nM - fm) : WGM;
        u.pm = fm + ((wgid % nig) % gsz); u.pn = (wgid % nig) / gsz; return true;
    }
};
__device__ __forceinline__ void rows_rstd(const float* part, int row0, int fq, float (&rs)[2][4]) {
    f32x4 q[2][4];
#pragma unroll
    for (int ai = 0; ai < 2; ++ai)
#pragma unroll
        for (int m = 0; m < 4; ++m) q[ai][m] = gld((const f32x4*)(part + (size_t)(row0 + ai * HALF + m * 16) * 16 + 4 * fq));
#pragma unroll
    for (int ai = 0; ai < 2; ++ai)
#pragma unroll
        for (int m = 0; m < 4; ++m) { float t = (q[ai][m].x + q[ai][m].y) + (q[ai][m].z + q[ai][m].w); t += __shfl_xor(t, 16); t += __shfl_xor(t, 32); rs[ai][m] = __builtin_amdgcn_rsqf(t * (1.0f / 1024.0f) + NORM_EPS); }
}
struct EpiStore {
    static constexpr bool PERM = true;
    bf16_t* O; int ldc; int nsig; const float* part; int qsc;
    __device__ __forceinline__ void operator()(const f32x4 (&acc)[2][2][4][2], const Unit& u, int wr, int wc, int fr, int fq) const {
        const int row0 = u.pm * BM + wr * 64 + fr, col0 = u.pn * BM + wc * 32 + 8 * fq; const bool sg = u.pn < nsig;
        float rsv[2][4];
#pragma unroll
        for (int ai = 0; ai < 2; ++ai)
#pragma unroll
            for (int m = 0; m < 4; ++m) rsv[ai][m] = 1.0f;
        if (part) rows_rstd(part, row0, fq, rsv);
        const float ts = !qsc ? 1.0f : ((unsigned)(u.pn - 12) < 2u ? 0.125f * LOG2E : ((unsigned)(u.pn - 18) < 2u ? 0.08838834764831845f * LOG2E : 1.0f));
#pragma unroll
        for (int ai = 0; ai < 2; ++ai)
#pragma unroll
            for (int m = 0; m < 4; ++m) { const size_t row = (size_t)(row0 + ai * HALF + m * 16); bf16_t* rowp = O + row * ldc + col0; const float rs = rsv[ai][m] * ts;
#pragma unroll
                for (int bj = 0; bj < 2; ++bj) { f32x4 v0 = acc[ai][bj][m][0] * rs, v1 = acc[ai][bj][m][1] * rs;
                    if (sg) {
#pragma unroll
                        for (int e = 0; e < 4; ++e) { v0[e] = fsigmoid(v0[e]); v1[e] = fsigmoid(v1[e]); } }
                    u32x4 w; w.x = cvt_pk_bf16(v0[0], v0[1]); w.y = cvt_pk_bf16(v0[2], v0[3]); w.z = cvt_pk_bf16(v1[0], v1[1]); w.w = cvt_pk_bf16(v1[2], v1[3]);
                    gst((u32x4*)(rowp + bj * HALF), w); } }
    }
};
struct EpiGate {
    static constexpr bool PERM = true;
    const bf16_t* G; int ldg; bf16_t* MIX; int ldm; int first;
    __device__ __forceinline__ void operator()(const f32x4 (&acc)[2][2][4][2], const Unit& u, int wr, int wc, int fr, int fq) const {
        const int row0 = u.pm * BM + wr * 64 + fr, col0 = u.pn * BM + wc * 32 + 8 * fq;
        u32x4 g[2][2], o[2][2];
#define EG_LOAD(slot, it) do { const size_t row_ = (size_t)(row0 + ((it) >> 2) * HALF + ((it) & 3) * 16); _Pragma("unroll") for (int bj = 0; bj < 2; ++bj) { \
            g[slot][bj] = gld((const u32x4*)(G + row_ * ldg + col0 + bj * HALF)); o[slot][bj] = (u32x4){0u, 0u, 0u, 0u}; if (!first) o[slot][bj] = gld((const u32x4*)(MIX + row_ * ldm + col0 + bj * HALF)); } } while (0)
        EG_LOAD(0, 0);
#pragma unroll
        for (int it = 0; it < 8; ++it) { const int ai = it >> 2, m = it & 3, sl = it & 1; const size_t row = (size_t)(row0 + ai * HALF + m * 16);
            if (it + 1 < 8) EG_LOAD(sl ^ 1, it + 1);
#pragma unroll
            for (int bj = 0; bj < 2; ++bj) { const u32x4 gg = g[sl][bj], oo = o[sl][bj]; const f32x4 v0 = acc[ai][bj][m][0], v1 = acc[ai][bj][m][1]; u32x4 w;
                w.x = cvt_pk_bf16(bf_lo(oo.x) + bf_lo(gg.x) * v0[0], bf_hi(oo.x) + bf_hi(gg.x) * v0[1]);
                w.y = cvt_pk_bf16(bf_lo(oo.y) + bf_lo(gg.y) * v0[2], bf_hi(oo.y) + bf_hi(gg.y) * v0[3]);
                w.z = cvt_pk_bf16(bf_lo(oo.z) + bf_lo(gg.z) * v1[0], bf_hi(oo.z) + bf_hi(gg.z) * v1[1]);
                w.w = cvt_pk_bf16(bf_lo(oo.w) + bf_lo(gg.w) * v1[2], bf_hi(oo.w) + bf_hi(gg.w) * v1[3]);
                gst((u32x4*)(MIX + row * ldm + col0 + bj * HALF), w); }
            asm volatile("" ::: "memory"); }
#undef EG_LOAD
    }
};
struct EpiResid {
    static constexpr bool PERM = true;
    const float* xin; float* xout; bf16_t* XB; float* part;
    __device__ __forceinline__ void operator()(const f32x4 (&acc)[2][2][4][2], const Unit& u, int wr, int wc, int fr, int fq) const {
        const int row0 = u.pm * BM + wr * 64 + fr, col0 = u.pn * BM + wc * 32 + 8 * fq;
        f32x4 xi[2][2][2];
#define ER_LOAD(slot, it) do { const size_t off_ = (size_t)(row0 + ((it) >> 2) * HALF + ((it) & 3) * 16) * DM + col0; _Pragma("unroll") for (int bj = 0; bj < 2; ++bj) _Pragma("unroll") for (int n = 0; n < 2; ++n) \
            xi[slot][bj][n] = gld((const f32x4*)(xin + off_ + bj * HALF + n * 4)); } while (0)
        ER_LOAD(0, 0);
#pragma unroll
        for (int it = 0; it < 8; ++it) { const int ai = it >> 2, m = it & 3, sl = it & 1; const size_t row = (size_t)(row0 + ai * HALF + m * 16), off = row * DM + col0; float ssq = 0.f;
            if (it + 1 < 8) ER_LOAD(sl ^ 1, it + 1);
#pragma unroll
            for (int bj = 0; bj < 2; ++bj) { const size_t c = off + bj * HALF;
                const f32x4 v0 = xi[sl][bj][0] + acc[ai][bj][m][0], v1 = xi[sl][bj][1] + acc[ai][bj][m][1];
                gst((f32x4*)(xout + c), v0); gst((f32x4*)(xout + c + 4), v1);
                ssq += ((v0.x * v0.x + v0.y * v0.y) + (v0.z * v0.z + v0.w * v0.w)) + ((v1.x * v1.x + v1.y * v1.y) + (v1.z * v1.z + v1.w * v1.w));
                if (XB) { u32x4 w; w.x = cvt_pk_bf16(v0.x, v0.y); w.y = cvt_pk_bf16(v0.z, v0.w); w.z = cvt_pk_bf16(v1.x, v1.y); w.w = cvt_pk_bf16(v1.z, v1.w); gst((u32x4*)(XB + c), w); } }
            if (XB) { ssq += __shfl_xor(ssq, 16); ssq += __shfl_xor(ssq, 32);
            if (fq == 0) gst(part + row * 16 + u.pn * 4 + wc, ssq); }
            asm volatile("" ::: "memory"); }
#undef ER_LOAD
    }
};
struct EpiSwiGLU {
    static constexpr bool PERM = true;
    bf16_t* U; int ldu; const float* part;
    __device__ __forceinline__ void operator()(const f32x4 (&acc)[2][2][4][2], const Unit& u, int wr, int wc, int fr, int fq) const {
        const int row0 = u.pm * BM + wr * 64 + fr, f0 = u.pn * 128 + wc * 32 + 8 * fq;
        float rsv[2][4]; rows_rstd(part, row0, fq, rsv);
#pragma unroll
        for (int ai = 0; ai < 2; ++ai)
#pragma unroll
            for (int m = 0; m < 4; ++m) { const size_t row = (size_t)(row0 + ai * HALF + m * 16); const float rs = rsv[ai][m]; float r[8];
#pragma unroll
                for (int n = 0; n < 2; ++n) { const f32x4 g = acc[ai][0][m][n] * rs, up = acc[ai][1][m][n] * rs;
#pragma unroll
                    for (int e = 0; e < 4; ++e) r[4 * n + e] = g[e] * fsigmoid(g[e]) * up[e]; }
                u32x4 w; w.x = cvt_pk_bf16(r[0], r[1]); w.y = cvt_pk_bf16(r[2], r[3]); w.z = cvt_pk_bf16(r[4], r[5]); w.w = cvt_pk_bf16(r[6], r[7]);
                gst((u32x4*)(U + row * ldu + f0), w); }
    }
};

template <class Epi, bool ALIGN_EPI>
__device__ __forceinline__ void gemm_phase(LAS unsigned char* lds, const Gemm g, const StaticOrder& S, const Epi& E) {
    const int tid = ltid(), wid = __builtin_amdgcn_readfirstlane(tid >> 6), lane = tid & 63, wr = wid >> 2, wc = wid & 3, fr = lane & 15, fq = lane >> 4;
    const int K = g.K, nt = K / BK, lda = g.lda;
    unsigned voffA[2], voffB[2];
#pragma unroll
    for (int i = 0; i < 2; ++i) { int R, C; stage_rc(tid * 16 + i * 8192, R, C); const int Rb = Epi::PERM ? ((R & ~31) + perm32(R & 31)) : R;
        voffA[i] = (unsigned)(R * lda + C) * 2u; voffB[i] = (unsigned)(Rb * K + C) * 2u; }
    const size_t kstep = (size_t)(BK * 2);
    const size_t hstepA = (size_t)HALF * lda * 2, hstepB = (size_t)HALF * K * 2;
    const size_t tstepA = 2 * hstepA, tstepB = 2 * hstepB;
    const unsigned ldsw = (unsigned)wid * 1024u;
    const int aoff = lds_byte(wr * 64 + fr, fq * 8), boff = lds_byte(wc * 32 + fr, fq * 8);
#define PG8_SA(b, h) (((b) * 2 + (h)) * HTB)
#define PG8_SB(b, h) ((4 + (b) * 2 + (h)) * HTB)
#define PG8_STAGE(bufoff, gbase, voff) do { _Pragma("unroll") for (int _i = 0; _i < 2; ++_i) \
        __builtin_amdgcn_global_load_lds((const unsigned*)((const char*)(gbase) + (voff)[_i]), (LAS unsigned*)(lds + (bufoff) + ldsw + _i * 8192), 16, 0, 0); } while (0)
#define PG8_LDA(dst, b, h) do { _Pragma("unroll") for (int m = 0; m < 4; ++m) _Pragma("unroll") for (int k = 0; k < 2; ++k) dst[m][k] = *(const LAS bf16x8*)(lds + PG8_SA(b, h) + aoff + m * 2048 + k * 1024); } while (0)
#define PG8_LDB(dst, b, h) do { _Pragma("unroll") for (int n = 0; n < 2; ++n) _Pragma("unroll") for (int k = 0; k < 2; ++k) dst[n][k] = *(const LAS bf16x8*)(lds + PG8_SB(b, h) + boff + n * 2048 + k * 1024); } while (0)
#define PG8_MMA(ai, bj, At, Bt) do { __builtin_amdgcn_s_setprio(1); _Pragma("unroll") for (int m = 0; m < 4; ++m) _Pragma("unroll") for (int n = 0; n < 2; ++n) _Pragma("unroll") for (int k = 0; k < 2; ++k) \
        acc[ai][bj][m][n] = __builtin_amdgcn_mfma_f32_16x16x32_bf16(Bt[n][k], At[m][k], acc[ai][bj][m][n], 0, 0, 0); __builtin_amdgcn_s_setprio(0); } while (0)
#define PG8_WAIT_V(n) asm volatile("s_waitcnt vmcnt(" #n ")" ::: "memory")
#define PG8_WAIT_L(n) asm volatile("s_waitcnt lgkmcnt(" #n ")" ::: "memory")
#define PG8_BAR __builtin_amdgcn_s_barrier()
#define PG8_SCHED __builtin_amdgcn_sched_barrier(0)
    Unit cur, nxt; int ui = 0;
    if (!S.next(0, cur)) return;
    f32x4 acc[2][2][4][2];
#pragma unroll
    for (int a = 0; a < 2; ++a)
#pragma unroll
        for (int b = 0; b < 2; ++b)
#pragma unroll
            for (int m = 0; m < 4; ++m)
#pragma unroll
                for (int n = 0; n < 2; ++n) acc[a][b][m][n] = (f32x4){0.f, 0.f, 0.f, 0.f};
    bf16x8 At[4][2], B0[2][2], B1[2][2];
    const char* cA = (const char*)g.A + (size_t)cur.pm * tstepA; const char* cB = (const char*)g.Bt + (size_t)cur.pn * tstepB;
    PG8_STAGE(PG8_SB(0, 0), cB, voffB); PG8_STAGE(PG8_SB(0, 1), cB + hstepB, voffB); PG8_STAGE(PG8_SA(0, 0), cA, voffA); PG8_STAGE(PG8_SA(0, 1), cA + hstepA, voffA);
    if (wr == 1) PG8_BAR;
    PG8_WAIT_V(2); PG8_BAR;
    PG8_STAGE(PG8_SB(1, 0), cB + kstep, voffB); PG8_STAGE(PG8_SA(1, 0), cA + kstep, voffA); PG8_STAGE(PG8_SB(1, 1), cB + hstepB + kstep, voffB);
    PG8_WAIT_V(6); PG8_BAR;
    for (;;) {
        const bool has_next = S.next(ui + 1, nxt);
        const char* nA = has_next ? (const char*)g.A + (size_t)nxt.pm * tstepA : cA; const char* nB = has_next ? (const char*)g.Bt + (size_t)nxt.pn * tstepB : cB;
        for (int t = 0; t < nt; t += 2) {
            const bool last = (t == nt - 2);
            const char* a1 = cA + (size_t)(t + 1) * kstep;
            const char* a2 = last ? nA : cA + (size_t)(t + 2) * kstep; const char* b2 = last ? nB : cB + (size_t)(t + 2) * kstep;
            const char* a3 = a2 + kstep; const char* b3 = b2 + kstep;
            PG8_LDB(B0, 0, 0); PG8_LDB(B1, 0, 1); PG8_SCHED; PG8_LDA(At, 0, 0); PG8_STAGE(PG8_SA(1, 1), a1 + hstepA, voffA);
            PG8_WAIT_V(8); PG8_WAIT_L(0); PG8_BAR; PG8_MMA(0, 0, At, B0); PG8_MMA(0, 1, At, B1); PG8_BAR; PG8_SCHED;
            PG8_LDA(At, 0, 1); PG8_STAGE(PG8_SB(0, 0), b2, voffB); PG8_STAGE(PG8_SB(0, 1), b2 + hstepB, voffB); PG8_STAGE(PG8_SA(0, 0), a2, voffA);
            PG8_WAIT_V(8); PG8_WAIT_L(0); PG8_BAR; PG8_MMA(1, 0, At, B0); PG8_MMA(1, 1, At, B1); PG8_BAR; PG8_SCHED;
            PG8_LDB(B0, 1, 0); PG8_LDB(B1, 1, 1); PG8_SCHED; PG8_LDA(At, 1, 0); PG8_STAGE(PG8_SA(0, 1), a2 + hstepA, voffA);
            PG8_WAIT_V(8); PG8_WAIT_L(0); PG8_BAR; PG8_MMA(0, 0, At, B0); PG8_MMA(0, 1, At, B1); PG8_BAR; PG8_SCHED;
            PG8_LDA(At, 1, 1); PG8_STAGE(PG8_SB(1, 0), b3, voffB); PG8_STAGE(PG8_SB(1, 1), b3 + hstepB, voffB); PG8_STAGE(PG8_SA(1, 0), a3, voffA);
            PG8_WAIT_V(8); PG8_WAIT_L(0); PG8_BAR; PG8_MMA(1, 0, At, B0); PG8_MMA(1, 1, At, B1); PG8_BAR; PG8_SCHED;
        }
        if constexpr (ALIGN_EPI) { if (wr == 0) PG8_BAR; }
        E(acc, cur, wr, wc, fr, fq);
        if (!has_next) break;
#pragma unroll
        for (int a = 0; a < 2; ++a)
#pragma unroll
            for (int b = 0; b < 2; ++b)
#pragma unroll
                for (int m = 0; m < 4; ++m)
#pragma unroll
                    for (int n = 0; n < 2; ++n) acc[a][b][m][n] = (f32x4){0.f, 0.f, 0.f, 0.f};
        cur = nxt; cA = nA; cB = nB; ++ui;
        if constexpr (ALIGN_EPI) { if (wr == 1) PG8_BAR; }
    }
    PG8_WAIT_V(0);
    if constexpr (!ALIGN_EPI) { if (wr == 0) PG8_BAR; }
    PG8_BAR;
#undef PG8_SA
#undef PG8_SB
#undef PG8_STAGE
#undef PG8_LDA
#undef PG8_LDB
#undef PG8_MMA
#undef PG8_WAIT_V
#undef PG8_WAIT_L
#undef PG8_BAR
#undef PG8_SCHED
}
}

namespace att {
typedef short v4i16_t __attribute__((ext_vector_type(4)));
__device__ __forceinline__ f32x16 mfma32(bf16x8 a, bf16x8 b, f32x16 c) { return __builtin_amdgcn_mfma_f32_32x32x16_bf16(a, b, c, 0, 0, 0); }
__device__ __forceinline__ s16x4 vtr(const LAS unsigned char* p) { return __builtin_bit_cast(s16x4, __builtin_amdgcn_ds_read_tr16_b64_v4i16((LAS v4i16_t*)p)); }

template <int DQK, int DK1, int DV, int MODE, bool QL = false>
__device__ __forceinline__ void flash_pass(LAS unsigned char* lds, const bf16_t* Q, int pitchQ, const bf16_t* K1, int pitchK1, const bf16_t* K2, int pitchK2,
                                           const bf16_t* V, int pitchV, int q0, float c2, float slope2, const f32x2* rope, f32x16 (&o)[DV / 32], float& l_out) {
    constexpr int PK = DQK * 2 + 16, PV = DV * 2 + 64, KB = 64 * PK, VB = 64 * PV, OFF_V = 2 * KB;
    constexpr int CPR1 = DK1 / 8, CPR2 = (DQK - DK1) / 8, CPRV = DV / 8, N1 = (64 * CPR1) / 512, NV = (64 * CPRV) / 512;
    constexpr int QOFF = 2 * KB + 2 * VB;
    static_assert(N1 >= 1 && NV >= 1 && QOFF + (QL ? 8 * 32 * PK : 0) <= LDS_CTRL, "tile geometry");
    const int tid = ltid(), lane = tid & 63, r32 = lane & 31, hi = lane >> 5, wid = __builtin_amdgcn_readfirstlane(tid >> 6);
    const int tq = q0 + 32 * wid + r32;
    bf16x8 qf[DQK / 16];
#pragma unroll
    for (int d0 = 0; d0 < DQK / 16; ++d0) qf[d0] = gld((const bf16x8*)(Q + (size_t)tq * pitchQ + 16 * d0 + 8 * hi));
    if constexpr (MODE == 2) {
        bf16x8 x1 = qf[4], x2 = qf[5];
#pragma unroll
        for (int e = 0; e < 8; e += 2) {
            const f32x2 cs0 = gld(rope + tq * 16 + 8 * hi + e), cs1 = gld(rope + tq * 16 + 8 * hi + e + 1);
            const float a0 = bf1((bf16_t)x1[e]), b0 = bf1((bf16_t)x2[e]), a1 = bf1((bf16_t)x1[e + 1]), b1 = bf1((bf16_t)x2[e + 1]);
            const unsigned w1 = cvt_pk_bf16(a0 * cs0.x - b0 * cs0.y, a1 * cs1.x - b1 * cs1.y), w2 = cvt_pk_bf16(a0 * cs0.y + b0 * cs0.x, a1 * cs1.y + b1 * cs1.x);
            x1[e] = (short)(w1 & 0xffff); x1[e + 1] = (short)(w1 >> 16); x2[e] = (short)(w2 & 0xffff); x2[e + 1] = (short)(w2 >> 16);
        }
        qf[4] = x1; qf[5] = x2;
    }
    LAS unsigned char* qaddr = lds + QOFF + (wid * 32 + r32) * PK + hi * 16;
    if constexpr (QL) {
#pragma unroll
        for (int d0 = 0; d0 < DQK / 16; ++d0) *(LAS bf16x8*)(qaddr + d0 * 32) = qf[d0];
    }
    constexpr bool D2 = true;
    u32x4 kregA[N1], kreg2A, vregA[NV], kregB[D2 ? N1 : 1], kreg2B, vregB[D2 ? NV : 1];
#define ATT_LOAD(R, t) do { \
        _Pragma("unroll") for (int i = 0; i < N1; ++i) { const int idx = tid + 512 * i, row = idx / CPR1, ch = idx % CPR1; kreg##R[i] = gld((const u32x4*)(K1 + (size_t)(64 * (t) + row) * pitchK1 + ch * 8)); } \
        if constexpr (CPR2 > 0) { if (tid < 64 * CPR2) { const int row = tid / (CPR2 > 0 ? CPR2 : 1), ch = tid % (CPR2 > 0 ? CPR2 : 1); kreg2##R = gld((const u32x4*)(K2 + (size_t)(64 * (t) + row) * pitchK2 + ch * 8)); } } \
        _Pragma("unroll") for (int i = 0; i < NV; ++i) { const int idx = tid + 512 * i, row = idx / CPRV, ch = idx % CPRV; vreg##R[i] = gld((const u32x4*)(V + (size_t)(64 * (t) + row) * pitchV + ch * 8)); } } while (0)
#define ATT_WRITE(R, buf) do { \
        _Pragma("unroll") for (int i = 0; i < N1; ++i) { const int idx = tid + 512 * i, row = idx / CPR1, ch = idx % CPR1; *(LAS u32x4*)(lds + (buf) * KB + row * PK + ch * 16) = kreg##R[i]; } \
        if constexpr (CPR2 > 0) { if (tid < 64 * CPR2) { const int row = tid / (CPR2 > 0 ? CPR2 : 1), ch = tid % (CPR2 > 0 ? CPR2 : 1); *(LAS u32x4*)(lds + (buf) * KB + row * PK + DK1 * 2 + ch * 16) = kreg2##R; } } \
        _Pragma("unroll") for (int i = 0; i < NV; ++i) { const int idx = tid + 512 * i, row = idx / CPRV, ch = idx % CPRV; *(LAS u32x4*)(lds + OFF_V + (buf) * VB + row * PV + ch * 16) = vreg##R[i]; } } while (0)
    const int NT = (q0 + 256) / 64, tlast = q0 / 64 + (wid >> 1);
    ATT_LOAD(A, NT - 1); ATT_WRITE(A, 0); if constexpr (D2) ATT_LOAD(A, NT - 2); __syncthreads();
    float m_run = 0.f, l_run = 0.f;
#pragma unroll
    for (int db = 0; db < DV / 32; ++db)
#pragma unroll
        for (int r = 0; r < 16; ++r) o[db][r] = 0.f;
    const int kfoff = r32 * PK + hi * 16;
    const int vfoff = (4 * hi + ((lane & 15) >> 2)) * PV + (16 * ((lane >> 4) & 1) + 4 * (lane & 3)) * 2;
#define ATT_TILE(MASKED, L, W) { \
        const int buf = (NT - 1 - t) & 1; \
        if constexpr (D2) { if (t > 1) ATT_LOAD(L, t - 2); } else { if (t > 0) ATT_LOAD(A, t - 1); } \
        if (t <= tlast) { \
            const bool first = (t == tlast); \
            const float mref = first ? 0.f : m_run; \
            const int dl0 = tq - 64 * t - 4 * hi; \
            const float sb0 = -slope2 * (float)dl0 - mref, sb1 = sb0 + 32.f * slope2; \
            f32x16 p0, p1; \
_Pragma("unroll") \
            for (int r = 0; r < 16; ++r) { const int cr_ = (r & 3) + 8 * (r >> 2); p0[r] = (MODE == 2) ? 0.f : __builtin_fmaf((float)cr_, slope2, sb0); p1[r] = (MODE == 2) ? 0.f : __builtin_fmaf((float)cr_, slope2, sb1); } \
            const LAS unsigned char* kb = lds + buf * KB + kfoff; \
            __builtin_amdgcn_s_setprio(1); \
_Pragma("unroll") \
            for (int d0 = 0; d0 < DQK / 16; ++d0) { \
                const bf16x8 k0 = *(const LAS bf16x8*)(kb + d0 * 32), k1 = *(const LAS bf16x8*)(kb + 32 * PK + d0 * 32); \
                bf16x8 qv; if constexpr (QL) qv = *(const LAS bf16x8*)(qaddr + d0 * 32); else qv = qf[d0]; \
                p0 = mfma32(k0, qv, p0); p1 = mfma32(k1, qv, p1); \
            } \
            __builtin_amdgcn_s_setprio(0); \
            if constexpr (MODE == 1) { \
                  \
                const int dmin = (q0 + 32 * wid) - (64 * t + 63), dmax = (q0 + 32 * wid + 31) - 64 * t; \
                const int tc = dmin > 512 ? 0 : ((dmin > 128 && dmax <= 512) ? 1 : ((dmin >= 0 && dmax <= 128) ? 2 : 3)); \
                if (tc == 0) { \
_Pragma("unroll") \
                    for (int r = 0; r < 16; ++r) { const int cr = (r & 3) + 8 * (r >> 2); const float bb = (((dl0 - cr) & 15) == 0) ? 0.f : -INFINITY; \
                        p0[r] += bb; p1[r] += bb; } \
                } else if (tc == 1) { \
_Pragma("unroll") \
                    for (int r = 0; r < 16; ++r) { const int cr = (r & 3) + 8 * (r >> 2), dlow = dl0 - cr; const float bb = ((dlow & 15) == 0) ? 1.0f : (((dlow & 3) == 0) ? 0.f : -INFINITY); \
                        p0[r] += bb; p1[r] += bb; } \
                } else if (tc == 2) { \
_Pragma("unroll") \
                    for (int r = 0; r < 16; ++r) { const int cr = (r & 3) + 8 * (r >> 2), dlow = dl0 - cr; const float bb = ((dlow & 15) == 0) ? 1.5849625007f : (((dlow & 3) == 0) ? 1.0f : 0.f); \
                        p0[r] += bb; p1[r] += bb; } \
                } else { \
_Pragma("unroll") \
                    for (int r = 0; r < 16; ++r) { \
                        const int cr = (r & 3) + 8 * (r >> 2); \
                        const int d0_ = dl0 - cr, d1_ = dl0 - 32 - cr; \
                        const bool a4 = (d0_ & 3) == 0, b16 = (d0_ & 15) == 0; \
                        const int n0 = ((unsigned)d0_ <= 128u ? 1 : 0) + ((a4 && ((unsigned)d0_ <= 512u)) ? 1 : 0) + ((b16 && d0_ >= 0) ? 1 : 0); \
                        const int n1 = ((unsigned)d1_ <= 128u ? 1 : 0) + ((a4 && ((unsigned)d1_ <= 512u)) ? 1 : 0) + ((b16 && d1_ >= 0) ? 1 : 0); \
                        const float b0 = n0 == 0 ? -INFINITY : (n0 == 1 ? 0.f : (n0 == 2 ? 1.0f : 1.5849625007f)); \
                        const float b1 = n1 == 0 ? -INFINITY : (n1 == 1 ? 0.f : (n1 == 2 ? 1.0f : 1.5849625007f)); \
                        p0[r] += b0; p1[r] += b1; \
                    } \
                } \
            } else { \
_Pragma("unroll") \
                for (int r = 0; r < 16; ++r) { \
                    const int cr = (r & 3) + 8 * (r >> 2); \
                    float s0, s1; \
                    if constexpr (MODE == 0) { s0 = p0[r]; s1 = p1[r]; } \
                    else { s0 = __builtin_fmaf(p0[r], c2, -mref); s1 = __builtin_fmaf(p1[r], c2, -mref); } \
                    if (MASKED) { if (cr > dl0) s0 = -INFINITY; if (cr > dl0 - 32) s1 = -INFINITY; } \
                    p0[r] = s0; p1[r] = s1; \
                } \
            } \
            float mx = fmaxf(p0[0], p1[0]); \
_Pragma("unroll") \
            for (int r = 1; r < 16; ++r) mx = fmaxf(mx, fmaxf(p0[r], p1[r])); \
            mx = fmaxf(mx, __shfl_xor(mx, 32)); \
            if (first || __any(mx > 8.0f)) { \
                const float delta = (first || mx > 8.0f) ? mx : 0.f; \
                const float alpha = __builtin_amdgcn_exp2f(-delta); \
                m_run = first ? mx : m_run + delta; \
                l_run *= alpha; \
_Pragma("unroll") \
                for (int r = 0; r < 16; ++r) { p0[r] -= delta; p1[r] -= delta; } \
_Pragma("unroll") \
                for (int db = 0; db < DV / 32; ++db) \
_Pragma("unroll") \
                    for (int r = 0; r < 16; ++r) o[db][r] *= alpha; \
            } \
            float ps = 0.f; \
_Pragma("unroll") \
            for (int r = 0; r < 16; ++r) { p0[r] = __builtin_amdgcn_exp2f(p0[r]); p1[r] = __builtin_amdgcn_exp2f(p1[r]); ps += p0[r] + p1[r]; } \
            l_run += ps; \
            bf16x8 pk[4]; \
            { u32x4 w; \
              w.x = cvt_pk_bf16(p0[0], p0[1]); w.y = cvt_pk_bf16(p0[2], p0[3]); w.z = cvt_pk_bf16(p0[4], p0[5]); w.w = cvt_pk_bf16(p0[6], p0[7]); pk[0] = __builtin_bit_cast(bf16x8, w); \
              w.x = cvt_pk_bf16(p0[8], p0[9]); w.y = cvt_pk_bf16(p0[10], p0[11]); w.z = cvt_pk_bf16(p0[12], p0[13]); w.w = cvt_pk_bf16(p0[14], p0[15]); pk[1] = __builtin_bit_cast(bf16x8, w); \
              w.x = cvt_pk_bf16(p1[0], p1[1]); w.y = cvt_pk_bf16(p1[2], p1[3]); w.z = cvt_pk_bf16(p1[4], p1[5]); w.w = cvt_pk_bf16(p1[6], p1[7]); pk[2] = __builtin_bit_cast(bf16x8, w); \
              w.x = cvt_pk_bf16(p1[8], p1[9]); w.y = cvt_pk_bf16(p1[10], p1[11]); w.z = cvt_pk_bf16(p1[12], p1[13]); w.w = cvt_pk_bf16(p1[14], p1[15]); pk[3] = __builtin_bit_cast(bf16x8, w); } \
            const LAS unsigned char* vb = lds + OFF_V + buf * VB + vfoff; \
s16x4 lo[2][DV / 32], hh[2][DV / 32]; \
            _Pragma("unroll") \
            for (int db = 0; db < DV / 32; ++db) { lo[0][db] = vtr(vb + 64 * db); hh[0][db] = vtr(vb + 8 * PV + 64 * db); } \
            _Pragma("unroll") \
            for (int ks = 0; ks < 4; ++ks) { \
                if (ks + 1 < 4) { \
                    _Pragma("unroll") \
                    for (int db = 0; db < DV / 32; ++db) { lo[(ks + 1) & 1][db] = vtr(vb + (16 * (ks + 1)) * PV + 64 * db); hh[(ks + 1) & 1][db] = vtr(vb + (16 * (ks + 1) + 8) * PV + 64 * db); } \
                } \
                __builtin_amdgcn_s_setprio(1); \
                _Pragma("unroll") \
                for (int db = 0; db < DV / 32; ++db) { \
                    const bf16x8 vf = (bf16x8){lo[ks & 1][db][0], lo[ks & 1][db][1], lo[ks & 1][db][2], lo[ks & 1][db][3], hh[ks & 1][db][0], hh[ks & 1][db][1], hh[ks & 1][db][2], hh[ks & 1][db][3]}; \
                    o[db] = mfma32(vf, pk[ks], o[db]); \
                } \
                __builtin_amdgcn_s_setprio(0); \
            } \
        } \
        if constexpr (D2) { if (t > 0) ATT_WRITE(W, buf ^ 1); } else { if (t > 0) ATT_WRITE(A, buf ^ 1); } \
        __syncthreads(); \
    }
    int t = NT - 1;
    { ATT_TILE(true, B, A) --t; ATT_TILE(true, A, B) --t; ATT_TILE(true, B, A) --t; ATT_TILE(true, A, B) --t; }
    for (; t >= 0; --t) { ATT_TILE(false, B, A) --t; ATT_TILE(false, A, B) --t; ATT_TILE(false, B, A) --t; ATT_TILE(false, A, B) }
#undef ATT_TILE
    l_out = l_run;
#undef ATT_LOAD
#undef ATT_WRITE
}

template <int DV>
__device__ __forceinline__ void store_o(LAS unsigned char* lds, bf16_t* O, int pitchO, int rowbase, int wave, int t2, const f32x16 (&o)[DV / 32], float sc) {
    constexpr int PO = DV * 2 + 16, CH = DV / 8;
    const int lane = t2 & 63, r32 = lane & 31, hi = lane >> 5;
    LAS unsigned char* st = lds + 75776 + wave * 8704;
#pragma unroll
    for (int db = 0; db < DV / 32; ++db)
#pragma unroll
        for (int g = 0; g < 4; ++g) {
            u32x2 w; w.x = cvt_pk_bf16(o[db][4 * g] * sc, o[db][4 * g + 1] * sc); w.y = cvt_pk_bf16(o[db][4 * g + 2] * sc, o[db][4 * g + 3] * sc);
            *(LAS u32x2*)(st + r32 * PO + 64 * db + 16 * g + 8 * hi) = w;
        }
#pragma unroll
    for (int i = 0; i < 32 * CH / 64; ++i) { const int id = lane + 64 * i, row = id / CH, ch = id % CH;
        const u32x4 v = *(const LAS u32x4*)(st + row * PO + ch * 16);
        gst((u32x4*)(O + (size_t)(rowbase + row) * pitchO + ch * 8), v); }
}
}

#define XB_TMO      128
#define XB_XCNT(j)  (256  + 64 * (j))
#define XB_XSUB(j)  (1280 + 64 * (j))
#define XB_XGEN(j)  (2304 + 64 * (j))
#define XB_TOP      3328
#define XB_TOPGEN   3392
#define XCD_BAR_WORDS 3456
#define XB_SPIN_CAP (1u << 18)

__device__ __forceinline__ unsigned xb_ld(unsigned* p)              { return __hip_atomic_load(p, __ATOMIC_RELAXED, __HIP_MEMORY_SCOPE_AGENT); }
__device__ __forceinline__ unsigned xb_add(unsigned* p, unsigned v) { return __hip_atomic_fetch_add(p, v, __ATOMIC_RELAXED, __HIP_MEMORY_SCOPE_AGENT); }
__device__ __forceinline__ unsigned xb_xcc_id() { return (unsigned)__builtin_amdgcn_s_getreg((3 << 11) | 20) & 0xFu; }
#define XB_SPIN(cond, bar) do { unsigned _sp = 0; while (cond) { __builtin_amdgcn_s_sleep(1); \
    if ((++_sp & 255u) == 0u) { if (xb_ld(&(bar)[XB_TMO])) break; if (_sp > XB_SPIN_CAP) { atomicAdd(&(bar)[XB_TMO], 1u); break; } } } } while (0)

struct XcdBarrier {
    unsigned* bar; unsigned x;
    volatile LAS unsigned* st;
};

__device__ __forceinline__ XcdBarrier xcd_barrier_post(unsigned* bar, volatile LAS unsigned* st) {
    XcdBarrier b; b.bar = bar; b.x = xb_xcc_id(); b.st = st;
    if (threadIdx.x == 0) (void)xb_add(&bar[XB_XCNT(b.x)], 1u);
    return b;
}
__device__ __forceinline__ void xcd_barrier_complete(unsigned* bar, unsigned x, unsigned& nloc, unsigned& nx) {
    const unsigned G = gridDim.x * gridDim.y * gridDim.z;
    unsigned sum, cnt, mine, sp = 0u;
    for (;;) {
        sum = 0u; cnt = 0u; mine = 0u;
#pragma unroll
        for (unsigned j = 0; j < 16; ++j) { const unsigned c = xb_ld(&bar[XB_XCNT(j)]); sum += c; cnt += (c > 0u) ? 1u : 0u; mine = (j == x) ? c : mine; }
        if (sum == G) break;
        __builtin_amdgcn_s_sleep(1);
        if ((++sp & 255u) == 0u) { if (xb_ld(&bar[XB_TMO])) break; if (sp > XB_SPIN_CAP) { atomicAdd(&bar[XB_TMO], 1u); break; } }
    }
    nloc = mine > 0u ? mine : 1u; nx = cnt > 0u ? cnt : 1u;
}

__device__ __forceinline__ void xcd_barrier(const XcdBarrier& b) {
    asm volatile("s_waitcnt vmcnt(0)" ::: "memory");
    __syncthreads();
    if (threadIdx.x == 0) {
        unsigned* bar = b.bar;
        __builtin_amdgcn_s_waitcnt(0);
        unsigned nloc = b.st[0], nx = b.st[1];
        if (nloc == 0u) { xcd_barrier_complete(bar, b.x, nloc, nx); b.st[0] = nloc; b.st[1] = nx; }
        const unsigned old = xb_add(&bar[XB_XSUB(b.x)], 1u);
        const unsigned gen = old / nloc;
        if (old + 1u == (gen + 1u) * nloc) {
            __builtin_amdgcn_fence(__ATOMIC_RELEASE, "agent");
            asm volatile("s_waitcnt vmcnt(0)" ::: "memory");
            const unsigned og = xb_add(&bar[XB_TOP], 1u);
            const unsigned tg = og / nx;
            if (og + 1u == (tg + 1u) * nx) xb_add(&bar[XB_TOPGEN], 1u);
            else XB_SPIN(xb_ld(&bar[XB_TOPGEN]) == tg, bar);
            __builtin_amdgcn_fence(__ATOMIC_ACQUIRE, "agent");
            xb_add(&bar[XB_XGEN(b.x)], 1u);
            asm volatile("s_waitcnt vmcnt(0)" ::: "memory");
        } else {
            XB_SPIN(xb_ld(&bar[XB_XGEN(b.x)]) == gen, bar);
            __builtin_amdgcn_fence(__ATOMIC_ACQUIRE, "agent");
            asm volatile("s_waitcnt vmcnt(0)" ::: "memory");
        }
    }
    __syncthreads();
}


struct Args { const float* in[18]; float* out; unsigned char* ws; int lo, hi, nchunk, pad; };

__device__ __forceinline__ int map_row(int n, int mode, int off) {
    if (mode == 0) return n + off;
    if (mode == 1) return n < 3744 ? n + 3072 : n - 3744;
    return 256 * (n >> 7) + 128 * (mode - 2) + (n & 127);
}
__device__ __forceinline__ void p0_transpose_item(const float* W, int K, int N, bf16_t* WT, int mode, LAS float* scr, int item, int lane, const float* gain = nullptr) {
    const int nblk = N / 32, kb = item / nblk, nb = item % nblk, k0 = 64 * kb, n0 = 32 * nb;
    f32x4 wv[8]; float gk[8];
#pragma unroll
    for (int i = 0; i < 8; ++i) { const int kk = 8 * i + (lane >> 3); wv[i] = gld((const f32x4*)(W + (size_t)(k0 + kk) * N + n0 + 4 * (lane & 7))); gk[i] = gain ? gld(gain + k0 + kk) : 1.0f; }
#pragma unroll
    for (int i = 0; i < 8; ++i) { const int kk = 8 * i + (lane >> 3); LAS float* d = scr + kk * 33 + 4 * (lane & 7); d[0] = wv[i].x * gk[i]; d[1] = wv[i].y * gk[i]; d[2] = wv[i].z * gk[i]; d[3] = wv[i].w * gk[i]; }
    asm volatile("s_waitcnt lgkmcnt(0)" ::: "memory");
    const int c = lane & 7;
#pragma unroll
    for (int j = 0; j < 4; ++j) { const int n = (lane >> 3) + 8 * j; const LAS float* s = scr + (8 * c) * 33 + n;
        u32x4 o; o.x = cvt_pk_bf16(s[0 * 33], s[1 * 33]); o.y = cvt_pk_bf16(s[2 * 33], s[3 * 33]); o.z = cvt_pk_bf16(s[4 * 33], s[5 * 33]); o.w = cvt_pk_bf16(s[6 * 33], s[7 * 33]);
        gst((u32x4*)(WT + (size_t)map_row(n0 + n, mode, 0) * K + k0 + 8 * c), o); }
    asm volatile("s_waitcnt lgkmcnt(0)" ::: "memory");
}

__device__ __forceinline__ void rms_row_to_bf16(const float* xrow, const float* gain, bf16_t* orow, int lane) {
    const f32x4* xr = (const f32x4*)xrow + lane; const f32x4* gr = (const f32x4*)gain + lane;
    f32x4 v[4]; float s = 0.f;
#pragma unroll
    for (int j = 0; j < 4; ++j) { v[j] = xr[64 * j]; s += (v[j].x * v[j].x + v[j].y * v[j].y) + (v[j].z * v[j].z + v[j].w * v[j].w); }
    const float rstd = __builtin_amdgcn_rsqf(wave_sum(s) * (1.f / DM) + NORM_EPS);
    u32x2* o8 = (u32x2*)orow + lane;
#pragma unroll
    for (int j = 0; j < 4; ++j) { const f32x4 g = gr[64 * j]; u32x2 w; w.x = cvt_pk_bf16(v[j].x * rstd * g.x, v[j].y * rstd * g.y); w.y = cvt_pk_bf16(v[j].z * rstd * g.z, v[j].w * rstd * g.w); o8[64 * j] = w; }
}

#define INPTR(k) ({ int _i = (k); asm volatile("" : "+s"(_i)); (const float*)(GAS const float*)a.in[_i]; })
__global__ void __launch_bounds__(512, 2) mega(Args a) {
    extern __shared__ __attribute__((aligned(16))) unsigned char lds_raw[];
    LAS unsigned char* lds = (LAS unsigned char*)lds_raw;
    cg::grid_group grid = cg::this_grid();
    const int G = gridDim.x, NGW = G * 8;
    const int nchunk = a.nchunk, NB = NBATCH / nchunk;
    if (threadIdx.x < 8) ((LAS unsigned*)(lds + LDS_CTRL))[threadIdx.x] = 0u;
    __syncthreads();
    const XcdBarrier xbar = xcd_barrier_post((unsigned*)(a.ws + WS_CTL) + 8192, (volatile LAS unsigned*)(lds + LDS_CTRL + 16));

    for (int step = a.lo; step < a.hi; ++step) {
        const int tid = ltid(), lane = tid & 63, wave = __builtin_amdgcn_readfirstlane(tid >> 6), gw = blockIdx.x * 8 + wave;
        unsigned char* ws = a.ws; int Tc = TTOK / nchunk;
        asm volatile("" : "+s"(ws), "+s"(Tc));
        ws = (unsigned char*)(GAS unsigned char*)ws;
        unsigned* ctl = (unsigned*)(ws + WS_CTL);
        f32x2* rope = (f32x2*)(ws + WS_ROPE);
        bf16_t* XN = (bf16_t*)(ws + WS_ACT);
        bf16_t* PROJ = XN + (size_t)Tc * 1024;
        bf16_t* QC = PROJ + (size_t)Tc * INP;
        bf16_t* KVC = QC + (size_t)Tc * 768;
        bf16_t* OC = KVC + (size_t)Tc * 1024;
        bf16_t* MIX = OC + (size_t)Tc * 512;
        bf16_t* OA = MIX + (size_t)Tc * 1024;
        bf16_t* OB = OA + (size_t)Tc * 512;
        float* PART = (float*)(OB + (size_t)Tc * 512);
        bf16_t* UB = PROJ;
        const float* x_in = INPTR(0);
        float* X = (float*)(GAS float*)a.out;
        if (step == 0 && EN(10)) {
            LAS float* scr = (LAS float*)(lds + wave * 16384);
            constexpr int I_IN = 16 * 213, I_UQ = 6 * 24, I_UKV = 4 * 32, I_BR = 8 * 32, I_OUT = 16 * 32, I_G = 16 * 88, I_D = 44 * 32;
            constexpr int I_L = I_IN + I_UQ + I_UKV + 3 * I_BR + I_OUT + 2 * I_G + I_D;
            for (int prep_ = 0; prep_ < (DUP == 10 ? 2 : 1); ++prep_)
            for (int it = gw; it < 2 * I_L; it += NGW) {
                const int l = it / I_L; int r = it % I_L;
                bf16_t* LW = (bf16_t*)(ws + WS_W) + (size_t)l * LW_TOTAL;
                if (r < I_IN) { p0_transpose_item(INPTR(2) + (size_t)l * 1024 * INW, 1024, INW, LW + LW_IN, 1, scr, r, lane, INPTR(1) + (size_t)l * DM); continue; } r -= I_IN;
                if (r < I_UQ) { p0_transpose_item(INPTR(6) + (size_t)l * 384 * 768, 384, 768, LW + LW_UQ, 0, scr, r, lane); continue; } r -= I_UQ;
                if (r < I_UKV) { p0_transpose_item(INPTR(8) + (size_t)l * 256 * 1024, 256, 1024, LW + LW_UKV, 0, scr, r, lane); continue; } r -= I_UKV;
                if (r < I_BR) { p0_transpose_item(INPTR(9) + (size_t)l * 512 * 1024, 512, 1024, LW + LW_A, 0, scr, r, lane); continue; } r -= I_BR;
                if (r < I_BR) { p0_transpose_item(INPTR(10) + (size_t)l * 512 * 1024, 512, 1024, LW + LW_B, 0, scr, r, lane); continue; } r -= I_BR;
                if (r < I_BR) { p0_transpose_item(INPTR(11) + (size_t)l * 512 * 1024, 512, 1024, LW + LW_C, 0, scr, r, lane); continue; } r -= I_BR;
                if (r < I_OUT) { p0_transpose_item(INPTR(12) + (size_t)l * 1024 * 1024, 1024, 1024, LW + LW_OUT, 0, scr, r, lane); continue; } r -= I_OUT;
                if (r < I_G) { p0_transpose_item(INPTR(14) + (size_t)l * 1024 * FF, 1024, FF, LW + LW_GU, 2, scr, r, lane, INPTR(13) + (size_t)l * DM); continue; } r -= I_G;
                if (r < I_G) { p0_transpose_item(INPTR(15) + (size_t)l * 1024 * FF, 1024, FF, LW + LW_GU, 3, scr, r, lane, INPTR(13) + (size_t)l * DM); continue; } r -= I_G;
                p0_transpose_item(INPTR(16) + (size_t)l * FF * 1024, FF, 1024, LW + LW_D, 0, scr, r, lane);
            }
            for (int i = blockIdx.x * 512 + tid; i < 2 * 12288; i += G * 512) { const int l = i / 12288, c = i % 12288;
                *(u32x4*)((bf16_t*)(ws + WS_W) + (size_t)l * LW_TOTAL + LW_IN + (size_t)INW * 1024 + (size_t)c * 8) = (u32x4){0u, 0u, 0u, 0u}; }
            for (int i = blockIdx.x * 512 + tid; i < SEQ * 16; i += G * 512) { const int pos = i >> 4, k = i & 15;
                const float invf = __builtin_amdgcn_exp2f(-(float)k * 0.8304820237218406f);
                const float ang = (float)pos * invf;
                const double rev = (double)ang * 0.15915494309189535; const float fr = (float)(rev - __builtin_floor(rev));
                rope[i] = (f32x2){__builtin_amdgcn_cosf(fr), __builtin_amdgcn_sinf(fr)}; }
            __syncthreads();
        } else if (step == 1 + nchunk * 2 * ((DUP >= 0) ? 11 : 10) && EN(11)) {
            const float* gain = INPTR(17);
            f32x4 gv[4];
#pragma unroll
            for (int j = 0; j < 4; ++j) gv[j] = gld((const f32x4*)gain + lane + 64 * j);
            for (int m0 = gw * 2; m0 < TTOK; m0 += NGW * 2) {
                f32x4 v[2][4];
#pragma unroll
                for (int rr = 0; rr < 2; ++rr) { const f32x4* xr = (const f32x4*)(X + (size_t)(m0 + rr) * DM) + lane;
#pragma unroll
                    for (int j = 0; j < 4; ++j) v[rr][j] = gld(xr + 64 * j); }
#pragma unroll
                for (int rr = 0; rr < 2; ++rr) { f32x4* xr = (f32x4*)(X + (size_t)(m0 + rr) * DM) + lane; float sq = 0.f;
#pragma unroll
                    for (int j = 0; j < 4; ++j) sq += (v[rr][j].x * v[rr][j].x + v[rr][j].y * v[rr][j].y) + (v[rr][j].z * v[rr][j].z + v[rr][j].w * v[rr][j].w);
                    const float rstd = __builtin_amdgcn_rsqf(wave_sum(sq) * (1.f / DM) + NORM_EPS);
#pragma unroll
                    for (int j = 0; j < 4; ++j) gst(xr + 64 * j, v[rr][j] * rstd * gv[j]); }
            }
        } else {
            constexpr int SPL = (DUP >= 0) ? 11 : 10;
            const int s0 = step - 1, ck = s0 / (2 * SPL), l = (s0 % (2 * SPL)) / SPL, idx = s0 % SPL, sp = (DUP >= 0 && idx > DUP) ? idx - 1 : idx, rep = (DUP >= 0 && idx == DUP + 1) ? 1 : 0;
            {
            const size_t trow0 = (size_t)ck * Tc;
            const bf16_t* LW = (const bf16_t*)(ws + WS_W) + (size_t)l * LW_TOTAL;
            const float* xcur = (l == 0) ? x_in : X;
            if (sp == 7 || (sp == 0 && l == 1) || (rep && sp == 6 && l == 1)) continue;
            if (sp == 0 && EN(0)) {
                for (int m0 = gw * 2; m0 < Tc; m0 += NGW * 2) {
                    f32x4 v[2][4];
#pragma unroll
                    for (int rr = 0; rr < 2; ++rr) { const f32x4* xr = (const f32x4*)(x_in + (trow0 + m0 + rr) * DM) + lane;
#pragma unroll
                        for (int j = 0; j < 4; ++j) v[rr][j] = gld(xr + 64 * j); }
#pragma unroll
                    for (int rr = 0; rr < 2; ++rr) { const int m = m0 + rr; u32x2* o8 = (u32x2*)(XN + (size_t)m * 1024) + lane; float ssq = 0.f;
#pragma unroll
                        for (int j = 0; j < 4; ++j) { const f32x4 x = v[rr][j]; ssq += (x.x * x.x + x.y * x.y) + (x.z * x.z + x.w * x.w); u32x2 w; w.x = cvt_pk_bf16(x.x, x.y); w.y = cvt_pk_bf16(x.z, x.w); gst(o8 + 64 * j, w); }
                        ssq = wave_sum(ssq);
                        if (lane < 16) gst(PART + (size_t)m * 16 + lane, lane == 0 ? ssq : 0.f); }
                }
            } else if (sp == 2 && EN(2)) {
                const float* gq = INPTR(5) + (size_t)l * 384; const float* gkv = INPTR(7) + (size_t)l * 256;
                for (int m0 = gw * 2; m0 < Tc; m0 += NGW * 2) {
                    u32x4 wq[2], wk[2]; float x1[2], x2[2]; f32x2 cs[2];
#pragma unroll
                    for (int rr = 0; rr < 2; ++rr) { const int m = m0 + rr; bf16_t* P = PROJ + (size_t)m * INP;
                        wq[rr] = (u32x4){0u, 0u, 0u, 0u}; wk[rr] = (u32x4){0u, 0u, 0u, 0u}; x1[rr] = 0.f; x2[rr] = 0.f; cs[rr] = (f32x2){0.f, 0.f};
                        if (lane < 48) wq[rr] = gld((const u32x4*)(P + C_CQ + lane * 8));
                        if (lane < 32) wk[rr] = gld((const u32x4*)(P + C_CKV + lane * 8));
                        if (lane < 16) { x1[rr] = bf1(gld(P + C_KPE + lane)); x2[rr] = bf1(gld(P + C_KPE + 16 + lane)); cs[rr] = gld(rope + (m & (SEQ - 1)) * 16 + lane); } }
#pragma unroll
                    for (int rr = 0; rr < 2; ++rr) { const int m = m0 + rr; bf16_t* P = PROJ + (size_t)m * INP;
                        { const u32x4 w = wq[rr];
                          float ss = bf_lo(w.x) * bf_lo(w.x) + bf_hi(w.x) * bf_hi(w.x) + bf_lo(w.y) * bf_lo(w.y) + bf_hi(w.y) * bf_hi(w.y) + bf_lo(w.z) * bf_lo(w.z) + bf_hi(w.z) * bf_hi(w.z) + bf_lo(w.w) * bf_lo(w.w) + bf_hi(w.w) * bf_hi(w.w);
                          const float rstd = __builtin_amdgcn_rsqf(wave_sum(ss) * (1.f / 384.f) + NORM_EPS);
                          if (lane < 48) { const f32x4 g0 = gld((const f32x4*)(gq + lane * 8)), g1 = gld((const f32x4*)(gq + lane * 8 + 4)); u32x4 o;
                              o.x = cvt_pk_bf16(bf_lo(w.x) * rstd * g0.x, bf_hi(w.x) * rstd * g0.y); o.y = cvt_pk_bf16(bf_lo(w.y) * rstd * g0.z, bf_hi(w.y) * rstd * g0.w);
                              o.z = cvt_pk_bf16(bf_lo(w.z) * rstd * g1.x, bf_hi(w.z) * rstd * g1.y); o.w = cvt_pk_bf16(bf_lo(w.w) * rstd * g1.z, bf_hi(w.w) * rstd * g1.w);
                              gst((u32x4*)(P + C_CQ + lane * 8), o); } }
                        { const u32x4 w = wk[rr];
                          float ss = bf_lo(w.x) * bf_lo(w.x) + bf_hi(w.x) * bf_hi(w.x) + bf_lo(w.y) * bf_lo(w.y) + bf_hi(w.y) * bf_hi(w.y) + bf_lo(w.z) * bf_lo(w.z) + bf_hi(w.z) * bf_hi(w.z) + bf_lo(w.w) * bf_lo(w.w) + bf_hi(w.w) * bf_hi(w.w);
                          const float rstd = __builtin_amdgcn_rsqf(wave_sum(ss) * (1.f / 256.f) + NORM_EPS);
                          if (lane < 32) { const f32x4 g0 = gld((const f32x4*)(gkv + lane * 8)), g1 = gld((const f32x4*)(gkv + lane * 8 + 4)); u32x4 o;
                              o.x = cvt_pk_bf16(bf_lo(w.x) * rstd * g0.x, bf_hi(w.x) * rstd * g0.y); o.y = cvt_pk_bf16(bf_lo(w.y) * rstd * g0.z, bf_hi(w.y) * rstd * g0.w);
                              o.z = cvt_pk_bf16(bf_lo(w.z) * rstd * g1.x, bf_hi(w.z) * rstd * g1.y); o.w = cvt_pk_bf16(bf_lo(w.w) * rstd * g1.z, bf_hi(w.w) * rstd * g1.w);
                              gst((u32x4*)(P + C_CKV + lane * 8), o); } }
                        if (lane < 16) { const unsigned w = cvt_pk_bf16(x1[rr] * cs[rr].x - x2[rr] * cs[rr].y, x1[rr] * cs[rr].y + x2[rr] * cs[rr].x);
                            gst(P + C_KPE + lane, (bf16_t)(w & 0xffff)); gst(P + C_KPE + 16 + lane, (bf16_t)(w >> 16)); }
                    }
                }
            } else if (sp == 4 && EN(4)) {
                unsigned* ctr = ctl + 64 * (1 + ck * 2 + l + 64 * rep);
                LAS int* s_unit = (LAS int*)(lds + LDS_CTRL);
                const float lam_init = (l == 0) ? 0.2f : 0.35550906f;
                float lam;
                { const float* lf = INPTR(3) + (size_t)l * 256; const float sa = wave_sum(lf[lane] * lf[64 + lane]), sb = wave_sum(lf[128 + lane] * lf[192 + lane]); lam = __expf(sa) - __expf(sb) + lam_init; lam = __uint_as_float(__builtin_amdgcn_readfirstlane(__float_as_uint(lam))); }
                const float* dgain = INPTR(4) + (size_t)l * 128;
                const int per_j = 16 * NB, nunits = 8 * per_j;
                for (;;) {
                    if (tid == 0) *s_unit = (int)atomicAdd(ctr, 1u);
                    __syncthreads();
                    const int u = *s_unit;
                    __syncthreads();
                    if (u >= nunits) break;
                    const int j = 7 - u / per_j, v = u % per_j, q0 = 256 * j;
                    if (PROBE_MIX >= 0 && rep) { const int mixer_ = v < 4 * NB ? 0 : (v < 8 * NB ? 1 : 2); if (mixer_ != PROBE_MIX) continue; }
                    const int t2 = ltid(), r32 = t2 & 31, hi = (t2 >> 5) & 1, tq = q0 + 32 * wave + r32;
                    if (v < 4 * NB) {
#ifndef NO_A
                        const int b = v >> 2, h = v & 3; bf16_t* base = PROJ + (size_t)b * SEQ * INP;
                        const float slope2 = __builtin_amdgcn_exp2f(-(float)(2 * h + 1)) * LOG2E, c2 = 0.125f * LOG2E;
                        f32x16 o1[4]; float l0, l1; unsigned o0p[4][8];
                        att::flash_pass<64, 64, 128, 0>(lds, base + C_AQ + h * 128, INP, base + C_AK + h * 128, INP, nullptr, 0, base + C_AV + h * 128, INP, q0, c2, slope2, nullptr, o1, l0);
                        l0 += __shfl_xor(l0, 32); { const float il = 1.0f / l0;
#pragma unroll
                            for (int db = 0; db < 4; ++db)
#pragma unroll
                                for (int r = 0; r < 16; r += 2) o0p[db][r >> 1] = cvt_pk_bf16(o1[db][r] * il, o1[db][r + 1] * il); }
                        att::flash_pass<64, 64, 128, 0>(lds, base + C_AQ + h * 128 + 64, INP, base + C_AK + h * 128 + 64, INP, nullptr, 0, base + C_AV + h * 128, INP, q0, c2, slope2, nullptr, o1, l1);
                        l1 += __shfl_xor(l1, 32); const float il1 = lam / l1; float ss = 0.f;
#pragma unroll
                        for (int db = 0; db < 4; ++db)
#pragma unroll
                            for (int r = 0; r < 16; r += 2) { const float d0 = bf_lo(o0p[db][r >> 1]) - il1 * o1[db][r], d1 = bf_hi(o0p[db][r >> 1]) - il1 * o1[db][r + 1]; o1[db][r] = d0; o1[db][r + 1] = d1; ss += d0 * d0 + d1 * d1; }
                        ss += __shfl_xor(ss, 32);
                        const float rstd = __builtin_amdgcn_rsqf(ss * (1.f / 128.f) + NORM_EPS) * (1.0f - lam_init);
#pragma unroll
                        for (int db = 0; db < 4; ++db)
#pragma unroll
                            for (int g = 0; g < 4; ++g) { const f32x4 gg = gld((const f32x4*)(dgain + 32 * db + 8 * g + 4 * hi));
#pragma unroll
                                for (int e = 0; e < 4; ++e) o1[db][4 * g + e] *= gg[e]; }
                        att::store_o<128>(lds, OA + (size_t)b * SEQ * 512 + h * 128, 512, q0 + 32 * wave, wave, t2, o1, rstd);
#endif
                    } else if (v < 8 * NB) {
#ifndef NO_B
                        const int vv = v - 4 * NB, b = vv >> 2, h = vv & 3; bf16_t* base = PROJ + (size_t)b * SEQ * INP;
                        const float slope2 = __builtin_amdgcn_exp2f(-(float)(2 * h + 2)) * LOG2E, c2 = 0.08838834764831845f * LOG2E;
                        f32x16 o[4]; float ll;
                        att::flash_pass<128, 128, 128, 1, true>(lds, base + C_BQ + h * 128, INP, base + C_BK + h * 128, INP, nullptr, 0, base + C_BV + h * 128, INP, q0, c2, slope2, nullptr, o, ll);
                        ll += __shfl_xor(ll, 32);
                        att::store_o<128>(lds, OB + (size_t)b * SEQ * 512 + h * 128, 512, q0 + 32 * wave, wave, t2, o, 1.0f / ll);
#endif
                    } else {
#ifndef NO_C
                        const int vv = v - 8 * NB, b = vv >> 3, h = vv & 7; const size_t r0 = (size_t)b * SEQ;
                        const float c2 = 0.10206207261596575f * LOG2E;
                        f32x16 o[2]; float ll;
                        att::flash_pass<96, 64, 64, 2>(lds, QC + r0 * 768 + h * 96, 768, KVC + r0 * 1024 + h * 128, 1024, PROJ + r0 * INP + C_KPE, INP, KVC + r0 * 1024 + h * 128 + 64, 1024, q0, c2, 0.f, rope, o, ll);
                        ll += __shfl_xor(ll, 32);
                        att::store_o<64>(lds, OC + r0 * 512 + h * 64, 512, q0 + 32 * wave, wave, t2, o, 1.0f / ll);
#endif
                    }
                }
            } else {
                const int nsub = (sp == 3) ? 2 : (sp == 5 ? 3 : 1);
                for (int sub = 0; sub < nsub; ++sub) {
                    pg8::Gemm g; pg8::StaticOrder S;
                    if (sp == 1 && EN(1)) { g = pg8::Gemm{XN, 1024, LW + LW_IN, Tc, INP, 1024}; S.init(Tc, INP, G, (int)blockIdx.x);
                        pg8::EpiStore E{PROJ, INP, 12, PART, 1}; pg8::gemm_phase<pg8::EpiStore, true>(lds, g, S, E); }
                    else if (sp == 3 && EN(3)) {
                        pg8::EpiStore E;
                        if (sub == 0) { g = pg8::Gemm{PROJ + C_CKV, INP, LW + LW_UKV, Tc, 1024, 256}; E = pg8::EpiStore{KVC, 1024, 0, nullptr, 0}; }
                        else { g = pg8::Gemm{PROJ + C_CQ, INP, LW + LW_UQ, Tc, 768, 384}; E = pg8::EpiStore{QC, 768, 0, nullptr, 0}; }
                        S.init(Tc, g.N, G, (int)blockIdx.x);
                        pg8::gemm_phase<pg8::EpiStore, true>(lds, g, S, E); }
                    else if (sp == 5 && EN(5)) {
                        S.init(Tc, 1024, G, (int)blockIdx.x);
                        if (sub == 0) g = pg8::Gemm{OA, 512, LW + LW_A, Tc, 1024, 512};
                        else if (sub == 1) g = pg8::Gemm{OB, 512, LW + LW_B, Tc, 1024, 512};
                        else g = pg8::Gemm{OC, 512, LW + LW_C, Tc, 1024, 512};
                        pg8::EpiGate E{PROJ + C_GATE + 1024 * sub, INP, MIX, 1024, sub == 0 ? 1 : 0};
                        pg8::gemm_phase<pg8::EpiGate, true>(lds, g, S, E); }
                    else if ((sp == 6 || sp == 9) && EN(6)) {
                        S.init(Tc, 1024, G, (int)blockIdx.x);
                        if (sp == 6) g = pg8::Gemm{MIX, 1024, LW + LW_OUT, Tc, 1024, 1024}; else g = pg8::Gemm{UB, FF, LW + LW_D, Tc, 1024, FF};
                        pg8::EpiResid E{(sp == 6 ? xcur : X) + trow0 * DM, rep ? (float*)(PART + (size_t)Tc * 16) : X + trow0 * DM, (sp == 9 && l == 1) ? (bf16_t*)nullptr : XN, PART};
                        pg8::gemm_phase<pg8::EpiResid, true>(lds, g, S, E); }
                    else if (sp == 8 && EN(8)) { g = pg8::Gemm{XN, 1024, LW + LW_GU, Tc, 2 * FF, 1024}; S.init(Tc, 2 * FF, G, (int)blockIdx.x);
                        pg8::EpiSwiGLU E{UB, FF, PART}; pg8::gemm_phase<pg8::EpiSwiGLU, true>(lds, g, S, E); }
                }
            }
            }
        }
        if (step + 1 < a.hi) { if (step == 0) grid.sync(); else xcd_barrier(xbar); }
    }
}

extern "C" void kernel_launch(void* const* d_in, const int* in_sizes, int n_in, void* d_out, int out_size, void* d_ws, size_t ws_size, hipStream_t stream) {
    static int grid = 0, nchunk = 0;
    if (grid == 0) {
        int dev = 0, cus = 0, per_cu = 0;
        if (hipGetDevice(&dev) != hipSuccess || hipDeviceGetAttribute(&cus, hipDeviceAttributeMultiprocessorCount, dev) != hipSuccess) { fprintf(stderr, "kernel_launch: device query failed\n"); grid = -1; return; }
        if (hipFuncSetAttribute((const void*)mega, hipFuncAttributeMaxDynamicSharedMemorySize, LDS_BYTES) != hipSuccess) { fprintf(stderr, "kernel_launch: hipFuncSetAttribute failed\n"); grid = -1; return; }
        if (hipOccupancyMaxActiveBlocksPerMultiprocessor(&per_cu, (const void*)mega, 512, LDS_BYTES) != hipSuccess || per_cu < 1) { fprintf(stderr, "kernel_launch: occupancy query says %d\n", per_cu); per_cu = 1; }
        (void)hipGetLastError();
        grid = cus;
        nchunk = 2;
        while (nchunk < 32 && WS_ACT + (size_t)(TTOK / nchunk) * ACT_COLS * 2 > ws_size) nchunk *= 2;
        if (n_in != 18 || out_size != TTOK * DM) { fprintf(stderr, "kernel_launch: unexpected shapes\n"); grid = -1; return; }
    }
    if (grid < 0) return;
    (void)hipMemsetAsync((char*)d_ws + WS_CTL, 0, 65536, stream);
    Args a{};
    for (int i = 0; i < 18; ++i) a.in[i] = (const float*)d_in[i];
    a.out = (float*)d_out; a.ws = (unsigned char*)d_ws; a.nchunk = nchunk; a.pad = 0;
    const int nsteps = 2 + nchunk * 2 * ((DUP >= 0) ? 11 : 10);
#if ONE_LAUNCH
    a.lo = 0; a.hi = nsteps;
    void* args[] = {&a};
    hipError_t e = hipLaunchCooperativeKernel((const void*)mega, dim3(grid), dim3(512), args, LDS_BYTES, stream);
    if (e != hipSuccess) fprintf(stderr, "cooperative launch failed: %s (grid %d)\n", hipGetErrorString(e), grid);
#else
    for (int s = 0; s < nsteps; ++s) { a.lo = s; a.hi = s + 1; hipLaunchKernelGGL(mega, dim3(grid), dim3(512), LDS_BYTES, stream, a); }
#endif
}
```
